# Optimizing an MI355X kernel written in HIP

```python
import math
import jax
import jax.numpy as jnp
from jax import lax
import numpy as np

D_MODEL = 2048
BATCH = 4
SEQ = 2048
DEPTH = 2

GRID_W = 64
CTX_LEN = 256
EPS = 1e-6
ROPE_THETA = 10000.0
Q_BLOCK = 128
MLA_HEADS = 4
MLA_Q_RANK = 512
MLA_KV_RANK = 512
MLA_NOPE = 128
MLA_ROPE = 64
MLA_V = 128
GQA_HEADS = 8
GQA_KV_HEADS = 2
GQA_HD = 128
GDN_HEADS = 4
GDN_DK = 128
GDN_DV = 128
GDN_CONV = 5
GDN_CHUNK = 64
N_BRANCH = 3
D_FF = 4 * D_MODEL
N_MOD = 6
IN_SPLITS = (MLA_Q_RANK, MLA_KV_RANK, MLA_ROPE,
             GQA_HEADS * GQA_HD, GQA_KV_HEADS * GQA_HD, GQA_KV_HEADS * GQA_HD,
             GDN_HEADS * (2 * GDN_DK + GDN_DV), 2 * GDN_HEADS, 2 * GDN_HEADS, GDN_HEADS * GDN_DV,
             N_BRANCH * D_MODEL)
D_IN = sum(IN_SPLITS)

kernel_name = 'hybrid_mla_gqa_gdn_prefix_dit_block'


def rmsnorm(x, g):
    xf = x.astype(jnp.float32)
    y = xf * lax.rsqrt(jnp.mean(xf * xf, axis=-1, keepdims=True) + EPS)
    return (y * g.astype(jnp.float32)).astype(x.dtype)


def l2norm(x):
    xf = x.astype(jnp.float32)
    return (xf * lax.rsqrt(jnp.sum(xf * xf, axis=-1, keepdims=True) + EPS)).astype(x.dtype)


def split_cols(p):
    out, off = [], 0
    for n in IN_SPLITS:
        out.append(p[..., off:off + n])
        off += n
    return out


def rope_1d(x, pos):
    half = x.shape[-1] // 2
    inv_freq = ROPE_THETA ** (-jnp.arange(half, dtype=jnp.float32) / half)
    ang = pos.astype(jnp.float32)[:, None] * inv_freq[None, :]
    cos = jnp.cos(ang)[:, None, :]
    sin = jnp.sin(ang)[:, None, :]
    xf = x.astype(jnp.float32)
    x1, x2 = xf[..., :half], xf[..., half:]
    return jnp.concatenate([x1 * cos - x2 * sin, x2 * cos + x1 * sin], axis=-1).astype(x.dtype)


def rope_2d(x, row, col):
    n = x.shape[-1] // 2
    return jnp.concatenate([rope_1d(x[..., :n], row), rope_1d(x[..., n:], col)], axis=-1)


def blocked_attention(q, k, v, scale):
    b, t, hq, d = q.shape
    hk = k.shape[2]
    grp = hq // hk
    nb = t // Q_BLOCK
    qb = q.reshape(b, nb, Q_BLOCK, hk, grp, d).transpose(1, 0, 2, 3, 4, 5)

    def one_block(qblk):
        s = jnp.einsum('bqhgd,bshd->bhgqs', qblk, k).astype(jnp.float32) * scale
        p = jax.nn.softmax(s, axis=-1).astype(v.dtype)
        return jnp.einsum('bhgqs,bshe->bqhge', p, v)

    o = lax.map(one_block, qb)
    return o.transpose(1, 0, 2, 3, 4, 5).reshape(b, t, hq, v.shape[-1])


def centred_dwconv(x, w):
    pad = GDN_CONV // 2
    return lax.conv_general_dilated(x, w[:, None, :].astype(x.dtype), window_strides=(1,),
                                    padding=((pad, pad),), dimension_numbers=('NWC', 'WIO', 'NWC'),
                                    feature_group_count=x.shape[-1])


def gated_delta_chunked(q, k, v, g, beta, s0):
    f32 = jnp.float32
    b, t, h, dk = q.shape
    cs = GDN_CHUNK
    n = t // cs

    def chunks(a):
        a = a.astype(f32).reshape((b, n, cs, h) + a.shape[3:])
        return jnp.moveaxis(a, (1, 3), (0, 2))

    qc = chunks(q) * (dk ** -0.5)
    kc, vc, bc = chunks(k), chunks(v), chunks(beta)
    gc = jnp.cumsum(chunks(g), axis=-1)
    lower = jnp.tril(jnp.ones((cs, cs), bool))
    strict = jnp.tril(jnp.ones((cs, cs), bool), -1)
    diff = gc[..., :, None] - gc[..., None, :]
    decay = jnp.where(lower, jnp.exp(jnp.where(lower, diff, 0.0)), 0.0)
    kb = kc * bc[..., None]
    a = jnp.where(strict, jnp.einsum('nbhid,nbhjd->nbhij', kb, kc) * decay, 0.0)
    eye = jnp.broadcast_to(jnp.eye(cs, dtype=f32), a.shape)
    tinv = lax.linalg.triangular_solve(eye + a, eye, left_side=True, lower=True, unit_diagonal=True)
    u = jnp.einsum('nbhij,nbhje->nbhie', tinv, vc * bc[..., None])
    w = jnp.einsum('nbhij,nbhjd->nbhid', tinv, kb * jnp.exp(gc)[..., None])
    qk = jnp.einsum('nbhid,nbhjd->nbhij', qc, kc) * decay

    def step(s, inp):
        q_i, k_i, u_i, w_i, g_i, qk_i = inp
        v_new = u_i - jnp.einsum('bhcd,bhde->bhce', w_i, s)
        o = (jnp.einsum('bhcd,bhde->bhce', q_i * jnp.exp(g_i)[..., None], s)
             + jnp.einsum('bhij,bhje->bhie', qk_i, v_new))
        g_last = g_i[..., -1:]
        s = (s * jnp.exp(g_last)[..., None]
             + jnp.einsum('bhcd,bhce->bhde', k_i * jnp.exp(g_last - g_i)[..., None], v_new))
        return s, o

    s_fin, o = lax.scan(step, s0.astype(f32), (qc, kc, u, w, gc, qk))
    o = jnp.moveaxis(o, (0, 2), (1, 3)).reshape(b, t, h, -1)
    return o, s_fin


def gdn_mixer(qkv_raw, beta_raw, a_raw, w_conv, a_log, dt_bias, s0_f, s0_b):
    b, t, _ = qkv_raw.shape
    qkv = jax.nn.silu(centred_dwconv(qkv_raw, w_conv))
    q, k, v = jnp.split(qkv, [GDN_HEADS * GDN_DK, 2 * GDN_HEADS * GDN_DK], axis=-1)
    q = l2norm(q.reshape(b, t, GDN_HEADS, GDN_DK))
    k = l2norm(k.reshape(b, t, GDN_HEADS, GDN_DK))
    v = v.reshape(b, t, GDN_HEADS, GDN_DV)
    beta = jax.nn.sigmoid(beta_raw.astype(jnp.float32)).reshape(b, t, 2, GDN_HEADS)
    g = -jnp.exp(a_log.astype(jnp.float32)) * jax.nn.softplus(
        a_raw.astype(jnp.float32).reshape(b, t, 2, GDN_HEADS) + dt_bias.astype(jnp.float32))
    o_f, s_f = gated_delta_chunked(q, k, v, g[:, :, 0], beta[:, :, 0], s0_f)
    rev = lambda arr: jnp.flip(arr, axis=1)
    o_b, s_b = gated_delta_chunked(rev(q), rev(k), rev(v), rev(g[:, :, 1]), rev(beta[:, :, 1]), s0_b)
    return o_f + rev(o_b), s_f, s_b


def gdn_output(o, gate_raw, g_out, dtype):
    b, t = o.shape[:2]
    gate = jax.nn.silu(gate_raw.astype(jnp.float32).reshape(b, t, GDN_HEADS, GDN_DV))
    return (rmsnorm(o, g_out) * gate).reshape(b, t, GDN_HEADS * GDN_DV).astype(dtype)


def project_mixers(h, w_in, g_mla_q, w_mla_qb, g_mla_kv, w_mla_kvb, g_gqa_q, g_gqa_k, pos):
    b, t, _ = h.shape
    (cq, ckv, kpe, gq, gk, gv, qkv, beta, dec, ogate, bgate) = split_cols(h @ w_in)
    qa = (rmsnorm(cq, g_mla_q) @ w_mla_qb).reshape(b, t, MLA_HEADS, MLA_NOPE + MLA_ROPE)
    kva = (rmsnorm(ckv, g_mla_kv) @ w_mla_kvb).reshape(b, t, MLA_HEADS, MLA_NOPE + MLA_V)
    q_nope, q_pe = qa[..., :MLA_NOPE], qa[..., MLA_NOPE:]
    k_nope, va = kva[..., :MLA_NOPE], kva[..., MLA_NOPE:]
    k_pe = kpe.reshape(b, t, 1, MLA_ROPE)
    qb = rmsnorm(gq.reshape(b, t, GQA_HEADS, GQA_HD), g_gqa_q)
    kb = rmsnorm(gk.reshape(b, t, GQA_KV_HEADS, GQA_HD), g_gqa_k)
    vb = gv.reshape(b, t, GQA_KV_HEADS, GQA_HD)
    if pos is not None:
        row, col = pos
        q_pe, k_pe = rope_2d(q_pe, row, col), rope_2d(k_pe, row, col)
        qb, kb = rope_2d(qb, row, col), rope_2d(kb, row, col)
    qa = jnp.concatenate([q_nope, q_pe], axis=-1)
    ka = jnp.concatenate([k_nope, jnp.broadcast_to(k_pe, (b, t, MLA_HEADS, MLA_ROPE))], axis=-1)
    return (qa, ka, va, qb, kb, vb, qkv, beta, dec, ogate, bgate)


def merge_branches(o_a, o_b, o_c, bgate, w_up_a, w_up_b, w_up_c, w_out):
    ga, gb, gc = jnp.split(jax.nn.sigmoid(bgate), N_BRANCH, axis=-1)
    y = ga * (o_a @ w_up_a) + gb * (o_b @ w_up_b) + gc * (o_c @ w_up_c)
    return y @ w_out


def sqrelu_mlp(h, w1, w2):
    return jnp.square(jax.nn.relu(h @ w1)) @ w2


def setup_inputs(seed: int = 0) -> dict:
    key = jax.random.key(seed)
    ks = jax.random.split(key, 26)
    f32 = jnp.float32
    L, D = DEPTH, D_MODEL

    def dense(k, fan_in, shape, gain=1.0):
        return jax.random.normal(k, shape, f32) * (gain * fan_in ** -0.5)

    def norm_gain(k, shape):
        return 1.0 + 0.05 * jax.random.normal(k, shape, f32)

    dt = jnp.exp(jax.random.uniform(ks[16], (L, 2, GDN_HEADS), f32, math.log(1e-3), math.log(1e-1)))
    return {
        'x': jax.random.normal(ks[0], (BATCH, SEQ, D), f32),
        'c': jax.random.normal(ks[1], (BATCH, D), f32),
        'ctx': jax.random.normal(ks[2], (BATCH, CTX_LEN, D), f32),
        'c_ctx': jax.random.normal(ks[3], (D,), f32),
        'w_mod': dense(ks[4], D, (L, D, N_MOD * D), 0.5),
        'b_mod': 0.02 * jax.random.normal(ks[5], (L, N_MOD * D), f32),
        'g_norm1': norm_gain(ks[6], (L, D)),
        'w_in': dense(ks[7], D, (L, D, D_IN)),
        'g_mla_q': norm_gain(ks[8], (L, MLA_Q_RANK)),
        'w_mla_qb': dense(ks[9], MLA_Q_RANK, (L, MLA_Q_RANK, MLA_HEADS * (MLA_NOPE + MLA_ROPE))),
        'g_mla_kv': norm_gain(ks[10], (L, MLA_KV_RANK)),
        'w_mla_kvb': dense(ks[11], MLA_KV_RANK, (L, MLA_KV_RANK, MLA_HEADS * (MLA_NOPE + MLA_V))),
        'g_gqa_q': norm_gain(ks[12], (L, GQA_HD)),
        'g_gqa_k': norm_gain(ks[13], (L, GQA_HD)),
        'w_conv': dense(ks[14], GDN_CONV, (L, GDN_CONV, GDN_HEADS * (2 * GDN_DK + GDN_DV))),
        'a_log': jnp.log(jax.random.uniform(ks[15], (L, 2, GDN_HEADS), f32, 1.0, 16.0)),
        'dt_bias': dt + jnp.log(-jnp.expm1(-dt)),
        'g_gdn_out': norm_gain(ks[17], (L, GDN_DV)),
        'w_up_a': dense(ks[18], MLA_HEADS * MLA_V, (L, MLA_HEADS * MLA_V, D)),
        'w_up_b': dense(ks[19], GQA_HEADS * GQA_HD, (L, GQA_HEADS * GQA_HD, D)),
        'w_up_c': dense(ks[20], GDN_HEADS * GDN_DV, (L, GDN_HEADS * GDN_DV, D)),
        'w_out': dense(ks[21], D, (L, D, D)),
        'g_norm2': norm_gain(ks[22], (L, D)),
        'w_ff1': dense(ks[23], D, (L, D, D_FF)),
        'w_ff2': dense(ks[24], D_FF, (L, D_FF, D), 0.5),
        'g_final': norm_gain(ks[25], (D,)),
    }


def reference(x, c, ctx, c_ctx, w_mod, b_mod, g_norm1, w_in, g_mla_q, w_mla_qb, g_mla_kv, w_mla_kvb,
              g_gqa_q, g_gqa_k, w_conv, a_log, dt_bias, g_gdn_out, w_up_a, w_up_b, w_up_c, w_out,
              g_norm2, w_ff1, w_ff2, g_final):
    b, t, _ = x.shape
    rows = t // GRID_W
    row = jnp.repeat(jnp.arange(rows, dtype=jnp.int32), GRID_W)
    col = jnp.tile(jnp.arange(GRID_W, dtype=jnp.int32), rows)
    pos = (row, col)
    mla_scale = (MLA_NOPE + MLA_ROPE) ** -0.5
    gqa_scale = GQA_HD ** -0.5
    s_zero = jnp.zeros((b, GDN_HEADS, GDN_DK, GDN_DV), jnp.float32)
    sc = jax.nn.silu(c)
    scc = jax.nn.silu(c_ctx)
    for l in range(DEPTH):
        last = l == DEPTH - 1
        mod_x = jnp.split((sc @ w_mod[l] + b_mod[l])[:, None, :], N_MOD, axis=-1)
        mod_c = jnp.split(scc @ w_mod[l] + b_mod[l], N_MOD, axis=-1)
        proj_w = (w_in[l], g_mla_q[l], w_mla_qb[l], g_mla_kv[l], w_mla_kvb[l], g_gqa_q[l], g_gqa_k[l])
        hx = rmsnorm(x, g_norm1[l]) * (1 + mod_x[1]) + mod_x[0]
        hc = rmsnorm(ctx, g_norm1[l]) * (1 + mod_c[1]) + mod_c[0]
        (qa_x, ka_x, va_x, qb_x, kb_x, vb_x, qkv_x, beta_x, dec_x, og_x, bg_x) = project_mixers(hx, *proj_w, pos)
        (qa_c, ka_c, va_c, qb_c, kb_c, vb_c, qkv_c, beta_c, dec_c, og_c, bg_c) = project_mixers(hc, *proj_w, None)
        oc_c, s_f, s_b = gdn_mixer(qkv_c, beta_c, dec_c, w_conv[l], a_log[l], dt_bias[l], s_zero, s_zero)
        oc_x, _, _ = gdn_mixer(qkv_x, beta_x, dec_x, w_conv[l], a_log[l], dt_bias[l], s_f, s_b)
        oa_x = blocked_attention(qa_x, jnp.concatenate([ka_x, ka_c], axis=1),
                                 jnp.concatenate([va_x, va_c], axis=1), mla_scale)
        ob_x = blocked_attention(qb_x, jnp.concatenate([kb_x, kb_c], axis=1),
                                 jnp.concatenate([vb_x, vb_c], axis=1), gqa_scale)
        mix_x = merge_branches(oa_x.reshape(b, t, -1), ob_x.reshape(b, t, -1),
                               gdn_output(oc_x, og_x, g_gdn_out[l], x.dtype), bg_x,
                               w_up_a[l], w_up_b[l], w_up_c[l], w_out[l])
        x = x + mod_x[2] * mix_x
        hx2 = rmsnorm(x, g_norm2[l]) * (1 + mod_x[4]) + mod_x[3]
        x = x + mod_x[5] * sqrelu_mlp(hx2, w_ff1[l], w_ff2[l])
        if not last:
            tc = ctx.shape[1]
            oa_c = blocked_attention(qa_c, ka_c, va_c, mla_scale)
            ob_c = blocked_attention(qb_c, kb_c, vb_c, gqa_scale)
            mix_c = merge_branches(oa_c.reshape(b, tc, -1), ob_c.reshape(b, tc, -1),
                                   gdn_output(oc_c, og_c, g_gdn_out[l], ctx.dtype), bg_c,
                                   w_up_a[l], w_up_b[l], w_up_c[l], w_out[l])
            ctx = ctx + mod_c[2] * mix_c
            hc2 = rmsnorm(ctx, g_norm2[l]) * (1 + mod_c[4]) + mod_c[3]
            ctx = ctx + mod_c[5] * sqrelu_mlp(hc2, w_ff1[l], w_ff2[l])
    return rmsnorm(x, g_final)
```

```cpp
#include <hip/hip_runtime.h>
#include <hip/hip_cooperative_groups.h>
#include <cstdio>
namespace cg = cooperative_groups;

#ifndef MULTI
#define MULTI 0
#endif
#ifndef PROBE
#define PROBE 0
#endif

typedef unsigned short u16;
#define LAS __attribute__((address_space(3)))
using bf16x8 = __attribute__((ext_vector_type(8))) __bf16;
using u32x4 = __attribute__((ext_vector_type(4))) unsigned;
using nt_f32x4 = __attribute__((ext_vector_type(4))) float;
__device__ __forceinline__ float4 ld_nt(const float* p) { const nt_f32x4 v = __builtin_nontemporal_load(reinterpret_cast<const nt_f32x4*>(p)); return make_float4(v[0], v[1], v[2], v[3]); }
__device__ __forceinline__ void st_nt(float* p, float4 v) { nt_f32x4 o = {v.x, v.y, v.z, v.w}; __builtin_nontemporal_store(o, reinterpret_cast<nt_f32x4*>(p)); }
using f32x16 = __attribute__((ext_vector_type(16))) float;
typedef short v4s __attribute__((ext_vector_type(4)));
typedef short v8s __attribute__((ext_vector_type(8)));

constexpr int NTHR = 512;
constexpr int DM = 2048;
constexpr int TPB = 2304;
constexpr int MROWS = 9216;
constexpr int DIN = 10832, DINP = 11008;
constexpr int DFF = 8192;
constexpr float EPS = 1e-6f;
constexpr float LOG2_THETA = 13.287712379549449f;
constexpr int C_CQ = 0, C_CKV = 512, C_KPE = 1024, C_GQ = 1088, C_GK = 2112, C_GV = 2368, C_QKV = 2624,
              C_BETA = 4160, C_DEC = 4168, C_OG = 4176, C_BG = 4688;

constexpr size_t O_WIN = 0;
constexpr size_t O_WQB = O_WIN + (size_t)DINP * 2048 * 2;
constexpr size_t O_WKVB = O_WQB + (size_t)768 * 512 * 2;
constexpr size_t O_WUPA = O_WKVB + (size_t)1024 * 512 * 2;
constexpr size_t O_WUPB = O_WUPA + (size_t)2048 * 512 * 2;
constexpr size_t O_WUPC = O_WUPB + (size_t)2048 * 1024 * 2;
constexpr size_t O_WOUT = O_WUPC + (size_t)2048 * 512 * 2;
constexpr size_t O_WFF1 = O_WOUT + (size_t)2048 * 2048 * 2;
constexpr size_t O_WFF2 = O_WFF1 + (size_t)8192 * 2048 * 2;
constexpr size_t O_XRES = O_WFF2 + (size_t)8192 * 2048 * 2;
constexpr size_t O_H = O_XRES + (size_t)MROWS * 2048 * 4;
constexpr size_t O_PROJ = O_H + (size_t)MROWS * 2048 * 2;
constexpr size_t O_MOD = O_PROJ + (size_t)MROWS * DINP * 2;
constexpr size_t O_CQN = O_MOD + (size_t)2 * 5 * 12288 * 4;
constexpr size_t O_CKVN = O_CQN + (size_t)MROWS * 512 * 2;
constexpr size_t O_KPE = O_CKVN + (size_t)MROWS * 512 * 2;
constexpr size_t O_GKN = O_KPE + (size_t)MROWS * 64 * 2;
constexpr size_t O_QRAW = O_GKN + (size_t)MROWS * 256 * 2;
constexpr size_t O_KVRAW = O_QRAW + (size_t)MROWS * 768 * 2;
constexpr size_t O_GDQ = O_KVRAW + (size_t)MROWS * 1024 * 2;
constexpr size_t O_GDK = O_GDQ + (size_t)MROWS * 512 * 2;
constexpr size_t O_GDV = O_GDK + (size_t)MROWS * 512 * 2;
constexpr size_t O_BETA = O_GDV + (size_t)MROWS * 512 * 2;
constexpr size_t O_GG = O_BETA + (size_t)MROWS * 8 * 4;
constexpr int NPREP = 1152;
constexpr size_t O_PU = O_GG + (size_t)MROWS * 8 * 4;
constexpr size_t O_PNW = O_PU + (size_t)NPREP * 64 * 128 * 4;
constexpr size_t O_PQT = O_PNW + (size_t)NPREP * 64 * 128 * 2;
constexpr size_t O_PKTT = O_PQT + (size_t)NPREP * 64 * 128 * 2;
constexpr size_t O_PQKD = O_PKTT + (size_t)NPREP * 64 * 128 * 2;
constexpr size_t O_PEGL = O_PQKD + (size_t)NPREP * 64 * 64 * 2;
constexpr size_t O_OF = O_PEGL + 8192;
constexpr size_t O_OB = O_OF + (size_t)MROWS * 512 * 4;
constexpr size_t O_OA = O_OB + (size_t)MROWS * 512 * 4;
constexpr size_t O_OBQ = O_OA + (size_t)MROWS * 512 * 2;
constexpr size_t O_OC = O_OBQ + (size_t)MROWS * 1024 * 2;
constexpr size_t O_CTR = O_OC + (size_t)MROWS * 512 * 2;
constexpr size_t O_ROPEG = O_CTR + 256;
constexpr size_t O_ROPEM = O_ROPEG + 64 * 32 * 8;
constexpr size_t O_GVC = O_ROPEM + 64 * 16 * 8;
constexpr size_t O_GQN = O_GVC + (size_t)MROWS * 256 * 2;
constexpr size_t O_BAR = O_GQN + (size_t)MROWS * 1024 * 2;
constexpr size_t WS_END = O_BAR + 3456 * 4;

constexpr int LDS_MAIN = 139264;
constexpr int LDS_BYTES = LDS_MAIN + 1024;

struct P {
  const float* in[26];
  float* out;
  unsigned char* ws;
  int lo, hi;
};

__device__ __forceinline__ u16 f2bf(float f) {
  unsigned u = __float_as_uint(f);
  u += 0x7fffu + ((u >> 16) & 1u);
  return (u16)(u >> 16);
}
__device__ __forceinline__ float bf2f(u16 h) { return __uint_as_float(((unsigned)h) << 16); }
typedef __bf16 v2bf_t __attribute__((ext_vector_type(2)));
typedef float v2f_t __attribute__((ext_vector_type(2)));
__device__ __forceinline__ unsigned pack2(float a, float b) { v2f_t f = {a, b}; v2bf_t r = __builtin_convertvector(f, v2bf_t); return __builtin_bit_cast(unsigned, r); }
__device__ __forceinline__ float bflo(unsigned u) { return __uint_as_float(u << 16); }
__device__ __forceinline__ float bfhi(unsigned u) { return __uint_as_float(u & 0xffff0000u); }
__device__ __forceinline__ int tid_() { int t = threadIdx.x; asm volatile("" : "+v"(t)); return t; }
__device__ __forceinline__ int tid() { int t = threadIdx.x; asm volatile("" : "+v"(t)); return t; }
__device__ __forceinline__ float wave_sum(float v) {
#pragma unroll
  for (int o = 32; o > 0; o >>= 1) v += __shfl_xor(v, o);
  return v;
}
__device__ __forceinline__ float siluf(float x) { return x / (1.f + __expf(-x)); }
__device__ __forceinline__ float sigmf(float x) { return 1.f / (1.f + __expf(-x)); }
__device__ __forceinline__ f32x16 mfma(bf16x8 a, bf16x8 b, f32x16 c) {
  return __builtin_amdgcn_mfma_f32_32x32x16_bf16(a, b, c, 0, 0, 0);
}
__device__ __forceinline__ bf16x8 ldsfrag(const unsigned char* p) { return *reinterpret_cast<const bf16x8*>(p); }
__device__ __forceinline__ bf16x8 asfrag(uint4 v) {
  u32x4 t = {v.x, v.y, v.z, v.w};
  return __builtin_bit_cast(bf16x8, t);
}

__device__ __forceinline__ void conv_tile(const float* __restrict__ W, int K, int N, int Npad, u16* __restrict__ Wt, int tile, float* sT) {
  const int ntn = Npad >> 8;
  const int kt = tile / ntn, nt = tile - kt * ntn;
  const int k0 = kt * 64, n0 = nt * 256;
  const int t = tid();
  {
    const int n4 = (t & 63) * 4, kk = t >> 6;
    float4 v[8];
#pragma unroll
    for (int j = 0; j < 8; ++j) {
      const int k = kk + 8 * j;
      v[j] = (n0 + n4 < N) ? ld_nt(W + (size_t)(k0 + k) * N + n0 + n4) : make_float4(0.f, 0.f, 0.f, 0.f);
    }
#pragma unroll
    for (int j = 0; j < 8; ++j) {
      const int k = kk + 8 * j;
      float* d = sT + k * 257 + n4;
      d[0] = v[j].x; d[1] = v[j].y; d[2] = v[j].z; d[3] = v[j].w;
    }
  }
  __syncthreads();
  {
    const int k8i = t & 7, nb = t >> 3;
#pragma unroll
    for (int i = 0; i < 4; ++i) {
      const int nn = nb + 64 * i;
      float x[8];
#pragma unroll
      for (int j = 0; j < 8; ++j) x[j] = sT[(k8i * 8 + j) * 257 + nn];
      uint4 o; o.x = pack2(x[0], x[1]); o.y = pack2(x[2], x[3]); o.z = pack2(x[4], x[5]); o.w = pack2(x[6], x[7]);
      *reinterpret_cast<uint4*>(Wt + (size_t)(n0 + nn) * K + k0 + k8i * 8) = o;
    }
  }
  __syncthreads();
}

__device__ __forceinline__ void phase_convert(const P& p, int l, unsigned char* lds, int group, int* sitem) {
  float* sT = reinterpret_cast<float*>(lds);
  unsigned char* ws = p.ws;
  const int n0 = 32 * 43, n1 = 8 * 3, n2 = 8 * 4, n3 = 8 * 8, n4 = 16 * 8, n5 = 8 * 8, n6 = 32 * 8, n7 = 32 * 32, n8 = 128 * 8;
  if (group == 0) {
    for (int it = blockIdx.x; it < n0 + n1 + n2; it += gridDim.x) {
      int r = it;
      if (r < n0) { conv_tile(p.in[7] + (size_t)l * 2048 * DIN, 2048, DIN, DINP, (u16*)(ws + O_WIN), r, sT); continue; }
      r -= n0;
      if (r < n1) { conv_tile(p.in[9] + (size_t)l * 512 * 768, 512, 768, 768, (u16*)(ws + O_WQB), r, sT); continue; }
      r -= n1;
      conv_tile(p.in[11] + (size_t)l * 512 * 1024, 512, 1024, 1024, (u16*)(ws + O_WKVB), r, sT);
    }
    return;
  }
  int* ctr = reinterpret_cast<int*>(ws + O_CTR) + 4 + l;
  const int total = n3 + n4 + n5 + n6 + n7 + n8;
  for (;;) {
    if (threadIdx.x == 0) *sitem = atomicAdd(ctr, 1);
    __syncthreads();
    int r = *sitem;
    __syncthreads();
    if (r >= total) break;
    if (r < n3) { conv_tile(p.in[18] + (size_t)l * 512 * 2048, 512, 2048, 2048, (u16*)(ws + O_WUPA), r, sT); continue; }
    r -= n3;
    if (r < n4) { conv_tile(p.in[19] + (size_t)l * 1024 * 2048, 1024, 2048, 2048, (u16*)(ws + O_WUPB), r, sT); continue; }
    r -= n4;
    if (r < n5) { conv_tile(p.in[20] + (size_t)l * 512 * 2048, 512, 2048, 2048, (u16*)(ws + O_WUPC), r, sT); continue; }
    r -= n5;
    if (r < n6) { conv_tile(p.in[21] + (size_t)l * 2048 * 2048, 2048, 2048, 2048, (u16*)(ws + O_WOUT), r, sT); continue; }
    r -= n6;
    if (r < n7) { conv_tile(p.in[23] + (size_t)l * 2048 * 8192, 2048, 8192, 8192, (u16*)(ws + O_WFF1), r, sT); continue; }
    r -= n7;
    conv_tile(p.in[24] + (size_t)l * 8192 * 2048, 8192, 2048, 2048, (u16*)(ws + O_WFF2), r, sT);
  }
}

__device__ __forceinline__ void phase_mod(const P& p, unsigned char* lds) {
  float* sS = reinterpret_cast<float*>(lds);
  float* sR = reinterpret_cast<float*>(lds + 40960);
  const int t = tid();
  bool inited = false;
  for (int it = (int)gridDim.x - 1 - (int)blockIdx.x; it < 192; it += gridDim.x) {
    if (!inited) {
      for (int i = t; i < 5 * 2048; i += NTHR) {
        int r = i >> 11, k = i & 2047;
        float v = (r < 4) ? p.in[1][r * 2048 + k] : p.in[3][k];
        sS[i] = siluf(v);
      }
      inited = true;
      __syncthreads();
    }
    const int l = it / 96, cgp = it % 96;
    const int nb = cgp * 128;
    const float* W = p.in[4] + (size_t)l * 2048 * 12288;
    const int c4 = t & 31, kq = t >> 5;
    float acc[5][4];
#pragma unroll
    for (int r = 0; r < 5; ++r)
#pragma unroll
      for (int j = 0; j < 4; ++j) acc[r][j] = 0.f;
#pragma unroll 2
    for (int k = kq; k < 2048; k += 16) {
      float4 w = ld_nt(W + (size_t)k * 12288 + nb + c4 * 4);
#pragma unroll
      for (int r = 0; r < 5; ++r) {
        float s = sS[r * 2048 + k];
        acc[r][0] += s * w.x; acc[r][1] += s * w.y; acc[r][2] += s * w.z; acc[r][3] += s * w.w;
      }
    }
#pragma unroll
    for (int r = 0; r < 5; ++r)
#pragma unroll
      for (int j = 0; j < 4; ++j) sR[(kq * 5 + r) * 128 + c4 * 4 + j] = acc[r][j];
    __syncthreads();
    float* MOD = reinterpret_cast<float*>(p.ws + O_MOD);
    for (int o = t; o < 640; o += NTHR) {
      int r = o >> 7, n = o & 127;
      float s = p.in[5][l * 12288 + nb + n];
#pragma unroll
      for (int q = 0; q < 16; ++q) s += sR[(q * 5 + r) * 128 + n];
      MOD[(size_t)(l * 5 + r) * 12288 + nb + n] = s;
    }
    __syncthreads();
  }
}

__device__ __forceinline__ float block_sum(float v, float* sred) {
  v = wave_sum(v);
  const int t = tid();
  if ((t & 63) == 0) sred[t >> 6] = v;
  __syncthreads();
  float s = 0.f;
#pragma unroll
  for (int i = 0; i < 8; ++i) s += sred[i];
  __syncthreads();
  return s;
}

__device__ __forceinline__ void phase_norm_mod(const P& p, int l, int which, bool from_input, bool skipctx, bool addpart) {
  const int t = tid(), lane = t & 63, w = t >> 6;
  float* XRES = reinterpret_cast<float*>(p.ws + O_XRES);
  u16* H = reinterpret_cast<u16*>(p.ws + O_H);
  const float* MOD = reinterpret_cast<const float*>(p.ws + O_MOD);
  const float* g = (which == 0 ? p.in[6] : p.in[22]) + l * 2048;
  for (int R = blockIdx.x * 8 + w; R < MROWS; R += gridDim.x * 8) {
    const int b = R / TPB, tt = R - b * TPB;
    const bool lat = tt < 2048;
    if (skipctx && !lat) continue;
    const float* src;
    if (from_input || (addpart && l == 0 && !lat)) src = lat ? (p.in[0] + ((size_t)b * 2048 + tt) * 2048) : (p.in[2] + ((size_t)b * 256 + (tt - 2048)) * 2048);
    else src = XRES + (size_t)R * 2048;
    float4 x[8];
    float ss = 0.f;
#pragma unroll
    for (int i = 0; i < 8; ++i) {
      x[i] = *reinterpret_cast<const float4*>(src + (lane + 64 * i) * 4);
    }
    const bool fold = addpart && !lat;
    if (fold) {
      const float* PART = reinterpret_cast<const float*>(p.ws + O_PU) + (size_t)(b * 256 + tt - 2048) * 2048;
#pragma unroll 1
      for (int sl = 0; sl < 8; ++sl) {
#pragma unroll
        for (int i = 0; i < 8; ++i) {
          const float4 pv = *reinterpret_cast<const float4*>(PART + (size_t)sl * 1024 * 2048 + (lane + 64 * i) * 4);
          x[i].x += pv.x; x[i].y += pv.y; x[i].z += pv.z; x[i].w += pv.w;
        }
      }
    }
#pragma unroll
    for (int i = 0; i < 8; ++i) ss += x[i].x * x[i].x + x[i].y * x[i].y + x[i].z * x[i].z + x[i].w * x[i].w;
    const int r = lat ? b : 4;
    const float* md = MOD + (size_t)(l * 5 + r) * 12288;
    float4 gva[8], sha[8], sca[8];
#pragma unroll
    for (int i = 0; i < 8; ++i) {
      const int d = (lane + 64 * i) * 4;
      gva[i] = *reinterpret_cast<const float4*>(g + d);
      sha[i] = *reinterpret_cast<const float4*>(md + (which ? 3 : 0) * 2048 + d);
      sca[i] = *reinterpret_cast<const float4*>(md + (which ? 4 : 1) * 2048 + d);
    }
    ss = wave_sum(ss);
    const float rs = rsqrtf(ss * (1.f / 2048.f) + EPS);
#pragma unroll
    for (int i = 0; i < 8; ++i) {
      const int d = (lane + 64 * i) * 4;
      const float4 gv = gva[i], sh = sha[i], sc = sca[i];
      const float y0 = x[i].x * rs * gv.x * (1.f + sc.x) + sh.x;
      const float y1 = x[i].y * rs * gv.y * (1.f + sc.y) + sh.y;
      const float y2 = x[i].z * rs * gv.z * (1.f + sc.z) + sh.z;
      const float y3 = x[i].w * rs * gv.w * (1.f + sc.w) + sh.w;
      uint2 o; o.x = pack2(y0, y1); o.y = pack2(y2, y3);
      *reinterpret_cast<uint2*>(H + (size_t)R * 2048 + d) = o;
      if (fold) *reinterpret_cast<float4*>(XRES + (size_t)R * 2048 + d) = x[i];
    }
  }
}

__device__ __forceinline__ void phase_final(const P& p) {
  const int t = tid(), lane = t & 63, w = t >> 6;
  const float* XRES = reinterpret_cast<const float*>(p.ws + O_XRES);
  const int stride = gridDim.x * 8;
  for (int q = blockIdx.x * 8 + w; q < 8192; q += 2 * stride) {
    const int q2 = q + stride;
    const bool has2 = q2 < 8192;
    const int qq2 = has2 ? q2 : q;
    const int R1 = (q >> 11) * TPB + (q & 2047), R2 = (qq2 >> 11) * TPB + (qq2 & 2047);
    float4 x1[8], x2[8];
    float s1 = 0.f, s2 = 0.f;
#pragma unroll
    for (int i = 0; i < 8; ++i) {
      x1[i] = *reinterpret_cast<const float4*>(XRES + (size_t)R1 * 2048 + (lane + 64 * i) * 4);
      x2[i] = *reinterpret_cast<const float4*>(XRES + (size_t)R2 * 2048 + (lane + 64 * i) * 4);
    }
#pragma unroll
    for (int i = 0; i < 8; ++i) {
      s1 += x1[i].x * x1[i].x + x1[i].y * x1[i].y + x1[i].z * x1[i].z + x1[i].w * x1[i].w;
      s2 += x2[i].x * x2[i].x + x2[i].y * x2[i].y + x2[i].z * x2[i].z + x2[i].w * x2[i].w;
    }
    s1 = wave_sum(s1); s2 = wave_sum(s2);
    const float r1 = rsqrtf(s1 * (1.f / 2048.f) + EPS), r2 = rsqrtf(s2 * (1.f / 2048.f) + EPS);
#pragma unroll
    for (int i = 0; i < 8; ++i) {
      const int d = (lane + 64 * i) * 4;
      const float4 gv = *reinterpret_cast<const float4*>(p.in[25] + d);
      float4 o; o.x = x1[i].x * r1 * gv.x; o.y = x1[i].y * r1 * gv.y; o.z = x1[i].z * r1 * gv.z; o.w = x1[i].w * r1 * gv.w;
      st_nt(p.out + (size_t)q * 2048 + d, o);
      if (has2) {
        float4 o2; o2.x = x2[i].x * r2 * gv.x; o2.y = x2[i].y * r2 * gv.y; o2.z = x2[i].z * r2 * gv.z; o2.w = x2[i].w * r2 * gv.w;
        st_nt(p.out + (size_t)q2 * 2048 + d, o2);
      }
    }
  }
}

using f32x4 = __attribute__((ext_vector_type(4))) float;
constexpr int G_BM = 256, G_BK = 64, G_HALF = 128, G_HTB = G_HALF * G_BK * 2;
__device__ __forceinline__ int g_lds_byte(int r, int c) { const int st = (r >> 4) * 2 + (c >> 5), rr = r & 15, cc = c & 31, ob = rr * 64 + cc * 2; return st * 1024 + (ob ^ (((ob >> 9) & 1) << 5)); }
__device__ __forceinline__ void g_stage_rc(int b, int& R, int& C) { const int st = b / 1024, sb = b % 1024, swz = sb ^ (((sb >> 9) & 1) << 5); R = (st >> 1) * 16 + swz / 64; C = (st & 1) * 32 + (swz % 64) / 2; }
__device__ __forceinline__ int g_perm32(int rho) { const int n = rho >> 4, i = rho & 15; return 8 * (i >> 2) + 4 * n + (i & 3); }
struct GUnit { int pm, pn, kt0, nkt; };
struct GOrder {
  int nM, nN, nwg, G, c, nt; bool skip, split, ctxk;
  __device__ __forceinline__ void init(int MT, int NT, int G_, int c_, int mode, int nt_) {
    split = (mode == 2) && (G_ == 256) && (NT == 8); ctxk = (mode == 3); skip = (mode == 1) || split || ctxk;
    nM = skip ? 32 : MT; nN = NT; nwg = nM * nN; G = G_; c = c_; nt = nt_; }
  __device__ __forceinline__ bool next(int i, GUnit& u) const {
    if (split && i >= 1) {
      if (i > 1) return false;
      const int ci = c >> 3, sl = c & 7;
      u.pm = 9 * (ci >> 3) + 8; u.pn = ci & 7; u.nkt = nt >> 3; u.kt0 = sl * u.nkt; return true;
    }
    u.kt0 = 0; u.nkt = nt;
    const int L = i * G + c;
    if (ctxk && L >= nwg) {
      const int ci = L - nwg; if (ci >= 48) return false;
      const int j = ci % 12; u.pm = 9 * (ci / 12) + 8; u.pn = (j < 3) ? 2 + j : 5 + j; return true;
    }
    if (L >= nwg) return false;
    int wgid = L; { const int q = nwg / 8, r = nwg % 8, xcd = wgid % 8, off = wgid / 8; wgid = (xcd < r ? xcd * (q + 1) : r * (q + 1) + (xcd - r) * q) + off; }
    const int nig = 8 * nN, gid = wgid / nig, fm = gid * 8, gsz = (nM - fm) < 8 ? (nM - fm) : 8;
    u.pm = fm + ((wgid % nig) % gsz); u.pn = (wgid % nig) / gsz;
    if (skip) u.pm += (u.pm >> 3);
    return true;
  }
};
template <bool PERM, class F>
__device__ __forceinline__ void gemm_phase(const u16* A, const u16* Bt, int K, int MT, int NT, unsigned char* lds_generic, F epi, int mode = 0, int cofs = 0) {
  LAS unsigned char* lds = (LAS unsigned char*)lds_generic;
  const int tid = tid_(), wid = __builtin_amdgcn_readfirstlane(tid >> 6), lane = tid & 63, wr = wid >> 2, wc = wid & 3, fr = lane & 15, fq = lane >> 4;
  const int nt = K / G_BK;
  unsigned voffA[2], voffB[2];
#pragma unroll
  for (int i = 0; i < 2; ++i) { int R, C; g_stage_rc(tid * 16 + i * 8192, R, C); const int Rb = PERM ? ((R & ~31) + g_perm32(R & 31)) : R;
    voffA[i] = (unsigned)(R * K + C) * 2u; voffB[i] = (unsigned)(Rb * K + C) * 2u; }
  const size_t kstep = (size_t)(G_BK * 2);
  const size_t hstep = (size_t)G_HALF * K * 2;
  const size_t tstep = 2 * hstep;
  const unsigned ldsw = (unsigned)wid * 1024u;
  const int aoff = g_lds_byte(wr * 64 + fr, fq * 8), boff = g_lds_byte(wc * 32 + fr, fq * 8);
#define PG8_SA(b, h) (((b) * 2 + (h)) * G_HTB)
#define PG8_SB(b, h) ((4 + (b) * 2 + (h)) * G_HTB)
#define PG8_STAGE(bufoff, gbase, voff) do { _Pragma("unroll") for (int _i = 0; _i < 2; ++_i) \
    __builtin_amdgcn_global_load_lds((const unsigned*)((const char*)(gbase) + (voff)[_i]), (LAS unsigned*)(lds + (bufoff) + ldsw + _i * 8192), 16, 0, 0); } while (0)
#define PG8_LDA(dst, b, h) do { _Pragma("unroll") for (int m = 0; m < 4; ++m) _Pragma("unroll") for (int k = 0; k < 2; ++k) dst[m][k] = *(const LAS bf16x8*)(lds + PG8_SA(b, h) + aoff + m * 2048 + k * 1024); } while (0)
#define PG8_LDB(dst, b, h) do { _Pragma("unroll") for (int n = 0; n < 2; ++n) _Pragma("unroll") for (int k = 0; k < 2; ++k) dst[n][k] = *(const LAS bf16x8*)(lds + PG8_SB(b, h) + boff + n * 2048 + k * 1024); } while (0)
#define PG8_MMA(ai, bj, At, Bt_) do { __builtin_amdgcn_s_setprio(1); _Pragma("unroll") for (int m = 0; m < 4; ++m) _Pragma("unroll") for (int n = 0; n < 2; ++n) _Pragma("unroll") for (int k = 0; k < 2; ++k) \
    acc[ai][bj][m][n] = __builtin_amdgcn_mfma_f32_16x16x32_bf16(Bt_[n][k], At[m][k], acc[ai][bj][m][n], 0, 0, 0); __builtin_amdgcn_s_setprio(0); } while (0)
#define PG8_WAIT_V(n) asm volatile("s_waitcnt vmcnt(" #n ")" ::: "memory")
#define PG8_WAIT_L(n) asm volatile("s_waitcnt lgkmcnt(" #n ")" ::: "memory")
#define PG8_BAR __builtin_amdgcn_s_barrier()
#define PG8_SCHED __builtin_amdgcn_sched_barrier(0)
  if ((int)blockIdx.x < cofs) return;
  GOrder S; S.init(MT, NT, (int)gridDim.x, (int)blockIdx.x - cofs, mode, nt);
  GUnit cur, nxt; int ui = 0;
  if (!S.next(0, cur)) return;
  f32x4 acc[2][2][4][2];
#pragma unroll
  for (int a = 0; a < 2; ++a)
#pragma unroll
    for (int b = 0; b < 2; ++b)
#pragma unroll
      for (int m = 0; m < 4; ++m)
#pragma unroll
        for (int n = 0; n < 2; ++n) acc[a][b][m][n] = (f32x4){0.f, 0.f, 0.f, 0.f};
  bf16x8 At[4][2], B0[2][2], B1[2][2];
  const char* cA = (const char*)A + (size_t)cur.pm * tstep + (size_t)cur.kt0 * kstep; const char* cB = (const char*)Bt + (size_t)cur.pn * tstep + (size_t)cur.kt0 * kstep;
  PG8_STAGE(PG8_SB(0, 0), cB, voffB); PG8_STAGE(PG8_SA(0, 0), cA, voffA); PG8_STAGE(PG8_SB(0, 1), cB + hstep, voffB); PG8_STAGE(PG8_SA(0, 1), cA + hstep, voffA);
  if (wr == 1) PG8_BAR;
  PG8_WAIT_V(4); PG8_BAR;
  PG8_STAGE(PG8_SB(1, 0), cB + kstep, voffB); PG8_STAGE(PG8_SA(1, 0), cA + kstep, voffA); PG8_STAGE(PG8_SB(1, 1), cB + hstep + kstep, voffB);
  PG8_WAIT_V(6); PG8_BAR;
  for (;;) {
    const bool has_next = S.next(ui + 1, nxt);
    const char* nA = has_next ? (const char*)A + (size_t)nxt.pm * tstep + (size_t)nxt.kt0 * kstep : cA; const char* nB = has_next ? (const char*)Bt + (size_t)nxt.pn * tstep + (size_t)nxt.kt0 * kstep : cB;
    const int cnkt = cur.nkt;
    for (int t = 0; t < cnkt; t += 2) {
      const bool last = (t == cnkt - 2);
      const char* a1 = cA + (size_t)(t + 1) * kstep;
      const char* a2 = last ? nA : cA + (size_t)(t + 2) * kstep; const char* b2 = last ? nB : cB + (size_t)(t + 2) * kstep;
      const char* a3 = a2 + kstep; const char* b3 = b2 + kstep;
      PG8_LDB(B0, 0, 0); PG8_SCHED; PG8_LDA(At, 0, 0); PG8_STAGE(PG8_SA(1, 1), a1 + hstep, voffA);
      PG8_WAIT_L(8); PG8_BAR; PG8_WAIT_L(0); PG8_MMA(0, 0, At, B0); PG8_BAR; PG8_SCHED;
      PG8_LDB(B1, 0, 1); PG8_STAGE(PG8_SB(0, 0), b2, voffB);
      PG8_BAR; PG8_WAIT_L(0); PG8_MMA(0, 1, At, B1); PG8_BAR;
      PG8_LDA(At, 0, 1); PG8_STAGE(PG8_SA(0, 0), a2, voffA);
      PG8_BAR; PG8_WAIT_L(0); PG8_MMA(1, 0, At, B0); PG8_BAR; PG8_SCHED;
      PG8_STAGE(PG8_SB(0, 1), b2 + hstep, voffB);
      PG8_WAIT_V(6); PG8_BAR; PG8_MMA(1, 1, At, B1); PG8_BAR;
      PG8_LDB(B0, 1, 0); PG8_SCHED; PG8_LDA(At, 1, 0); PG8_STAGE(PG8_SA(0, 1), a2 + hstep, voffA);
      PG8_WAIT_L(8); PG8_BAR; PG8_WAIT_L(0); PG8_MMA(0, 0, At, B0); PG8_BAR; PG8_SCHED;
      PG8_LDB(B1, 1, 1); PG8_STAGE(PG8_SB(1, 0), b3, voffB);
      PG8_BAR; PG8_WAIT_L(0); PG8_MMA(0, 1, At, B1); PG8_BAR;
      PG8_LDA(At, 1, 1); PG8_STAGE(PG8_SA(1, 0), a3, voffA);
      PG8_BAR; PG8_WAIT_L(0); PG8_MMA(1, 0, At, B0); PG8_BAR; PG8_SCHED;
      PG8_STAGE(PG8_SB(1, 1), b3 + hstep, voffB);
      PG8_WAIT_V(6); PG8_BAR; PG8_MMA(1, 1, At, B1); PG8_BAR;
    }
    {
      const int part = (cur.nkt != nt) ? (cur.kt0 / cur.nkt) : -1;
      const int row0 = cur.pm * G_BM + wr * 64 + fr;
      const int col0 = cur.pn * G_BM + wc * 32 + (PERM ? 8 * fq : 4 * fq);
#pragma unroll
      for (int ai = 0; ai < 2; ++ai)
#pragma unroll
        for (int m = 0; m < 4; ++m) {
          const int row = row0 + ai * G_HALF + m * 16;
#pragma unroll
          for (int bj = 0; bj < 2; ++bj)
#pragma unroll
            for (int n = 0; n < 2; ++n) epi(row, col0 + bj * G_HALF + (PERM ? 4 * n : 16 * n), acc[ai][bj][m][n], part);
        }
    }
    if (!has_next) break;
#pragma unroll
    for (int a = 0; a < 2; ++a)
#pragma unroll
      for (int b = 0; b < 2; ++b)
#pragma unroll
        for (int m = 0; m < 4; ++m)
#pragma unroll
          for (int n = 0; n < 2; ++n) acc[a][b][m][n] = (f32x4){0.f, 0.f, 0.f, 0.f};
    cur = nxt; cA = nA; cB = nB; ++ui;
  }
  PG8_WAIT_V(0);
  if (wr == 0) PG8_BAR;
  PG8_BAR;
#undef PG8_SA
#undef PG8_SB
#undef PG8_STAGE
#undef PG8_LDA
#undef PG8_LDB
#undef PG8_MMA
#undef PG8_WAIT_V
#undef PG8_WAIT_L
#undef PG8_BAR
#undef PG8_SCHED
}

__device__ __forceinline__ void st_bf16x4(u16* dst, f32x4 v) {
  uint2 o; o.x = pack2(v[0], v[1]); o.y = pack2(v[2], v[3]);
  *reinterpret_cast<uint2*>(dst) = o;
}

__device__ __forceinline__ void unpack8(uint4 v, float (&x)[8]) {
  x[0] = bflo(v.x); x[1] = bfhi(v.x); x[2] = bflo(v.y); x[3] = bfhi(v.y); x[4] = bflo(v.z); x[5] = bfhi(v.z); x[6] = bflo(v.w); x[7] = bfhi(v.w);
}
__device__ __forceinline__ void phase_post(const P& p, int l) {
  unsigned char* ws = p.ws;
  const u16* __restrict__ PROJ = reinterpret_cast<const u16*>(ws + O_PROJ);
  const int t = tid(), lane = t & 63, w = __builtin_amdgcn_readfirstlane(t >> 6);
  const int gw = blockIdx.x * 8 + w, nw = gridDim.x * 8;
  for (int item = gw; item < 1152 * 6; item += nw) {
    const int role = item / 1152;
    const int rg = item - role * 1152;
    const int R0 = rg * 8;
    const int b = R0 / TPB, tt0 = R0 - b * TPB;
    const bool lat = tt0 < 2048;
    if (role < 4) {
      const int h = role;
      const float* wc = p.in[14] + (size_t)l * 5 * 1536;
      const int segpos0 = lat ? tt0 : tt0 - 2048;
      const int seglen = lat ? 2048 : 256;
      unsigned xin[3][12];
#pragma unroll
      for (int part = 0; part < 3; ++part)
#pragma unroll
        for (int rr = 0; rr < 12; ++rr) {
          const int sp = segpos0 + rr - 2;
          xin[part][rr] = (sp >= 0 && sp < seglen) ? *reinterpret_cast<const unsigned*>(PROJ + (size_t)(R0 + rr - 2) * DINP + C_QKV + part * 512 + h * 128 + 2 * lane) : 0u;
        }
      float2 wv[3][5];
#pragma unroll
      for (int part = 0; part < 3; ++part)
#pragma unroll
        for (int j = 0; j < 5; ++j) wv[part][j] = *reinterpret_cast<const float2*>(wc + j * 1536 + part * 512 + h * 128 + 2 * lane);
      u16* GQ = reinterpret_cast<u16*>(ws + O_GDQ) + h * 128 + 2 * lane;
      u16* GK = reinterpret_cast<u16*>(ws + O_GDK) + h * 128 + 2 * lane;
      u16* GV = reinterpret_cast<u16*>(ws + O_GDV) + h * 128 + 2 * lane;
#pragma unroll
      for (int rr = 0; rr < 8; ++rr) {
        float v0[3], v1[3];
#pragma unroll
        for (int part = 0; part < 3; ++part) {
          float s0 = 0.f, s1 = 0.f;
#pragma unroll
          for (int j = 0; j < 5; ++j) { s0 += wv[part][j].x * bflo(xin[part][rr + j]); s1 += wv[part][j].y * bfhi(xin[part][rr + j]); }
          v0[part] = siluf(s0); v1[part] = siluf(s1);
        }
        const float sq = wave_sum(v0[0] * v0[0] + v1[0] * v1[0]);
        const float sk = wave_sum(v0[1] * v0[1] + v1[1] * v1[1]);
        const float rq = rsqrtf(sq + EPS) * 0.08838834764831845f;
        const float rk = rsqrtf(sk + EPS);
        const size_t ro = (size_t)(R0 + rr) * 512;
        *reinterpret_cast<unsigned*>(GQ + ro) = pack2(v0[0] * rq, v1[0] * rq);
        *reinterpret_cast<unsigned*>(GK + ro) = pack2(v0[1] * rk, v1[1] * rk);
        *reinterpret_cast<unsigned*>(GV + ro) = pack2(v0[2], v1[2]);
      }
    } else if (role == 4) {
      uint4 vq[8], vk[8];
#pragma unroll
      for (int rr = 0; rr < 8; ++rr) {
        vq[rr] = *reinterpret_cast<const uint4*>(PROJ + (size_t)(R0 + rr) * DINP + C_CQ + lane * 8);
        vk[rr] = *reinterpret_cast<const uint4*>(PROJ + (size_t)(R0 + rr) * DINP + C_CKV + lane * 8);
      }
      float gq[8], gk[8];
#pragma unroll
      for (int j = 0; j < 8; ++j) { gq[j] = p.in[8][l * 512 + lane * 8 + j]; gk[j] = p.in[10][l * 512 + lane * 8 + j]; }
#pragma unroll
      for (int rr = 0; rr < 8; ++rr) {
#pragma unroll
        for (int which = 0; which < 2; ++which) {
          float x[8];
          unpack8(which ? vk[rr] : vq[rr], x);
          float ss = 0.f;
#pragma unroll
          for (int j = 0; j < 8; ++j) ss += x[j] * x[j];
          ss = wave_sum(ss);
          const float rs = rsqrtf(ss * (1.f / 512.f) + EPS);
          uint4 o;
          if (which) { o.x = pack2(x[0] * rs * gk[0], x[1] * rs * gk[1]); o.y = pack2(x[2] * rs * gk[2], x[3] * rs * gk[3]); o.z = pack2(x[4] * rs * gk[4], x[5] * rs * gk[5]); o.w = pack2(x[6] * rs * gk[6], x[7] * rs * gk[7]); }
          else { o.x = pack2(x[0] * rs * gq[0], x[1] * rs * gq[1]); o.y = pack2(x[2] * rs * gq[2], x[3] * rs * gq[3]); o.z = pack2(x[4] * rs * gq[4], x[5] * rs * gq[5]); o.w = pack2(x[6] * rs * gq[6], x[7] * rs * gq[7]); }
          u16* dst = reinterpret_cast<u16*>(ws + (which ? O_CKVN : O_CQN)) + (size_t)(R0 + rr) * 512;
          *reinterpret_cast<uint4*>(dst + lane * 8) = o;
        }
      }
    } else {
      const int hd = lane >> 5, i = lane & 31;
      const float* g = p.in[13] + l * 128;
      const float g0 = g[i], g1 = g[i + 32], g2 = g[64 + i], g3 = g[96 + i];
      u16 xr[8][4];
      u16 kr[8][2];
      u16 br[8];
      uint2 gvr[8];
#pragma unroll
      for (int rr = 0; rr < 8; ++rr) {
        const u16* pr = PROJ + (size_t)(R0 + rr) * DINP;
        const u16* src = pr + C_GK + hd * 128;
        xr[rr][0] = src[i]; xr[rr][1] = src[i + 32]; xr[rr][2] = src[64 + i]; xr[rr][3] = src[96 + i];
        const int ki = lane & 15, kb = ((lane >> 4) & 1) * 32;
        kr[rr][0] = pr[C_KPE + kb + ki]; kr[rr][1] = pr[C_KPE + kb + 16 + ki];
        br[rr] = pr[C_BETA + (lane & 15)];
        gvr[rr] = *reinterpret_cast<const uint2*>(pr + C_GV + lane * 4);
      }
#pragma unroll
      for (int rr = 0; rr < 8; ++rr) {
        const int R = R0 + rr, tt = tt0 + rr;
        float x0 = bf2f(xr[rr][0]), x1 = bf2f(xr[rr][1]), x2 = bf2f(xr[rr][2]), x3 = bf2f(xr[rr][3]);
        float ss = x0 * x0 + x1 * x1 + x2 * x2 + x3 * x3;
#pragma unroll
        for (int o = 16; o > 0; o >>= 1) ss += __shfl_xor(ss, o);
        const float rs = rsqrtf(ss * (1.f / 128.f) + EPS);
        x0 *= rs * g0; x1 *= rs * g1; x2 *= rs * g2; x3 *= rs * g3;
        if (lat) {
          const float2 r1 = reinterpret_cast<const float2*>(ws + O_ROPEG)[(tt >> 6) * 32 + i];
          const float2 r2 = reinterpret_cast<const float2*>(ws + O_ROPEG)[(tt & 63) * 32 + i];
          const float y0 = x0 * r1.x - x1 * r1.y, y1 = x1 * r1.x + x0 * r1.y;
          const float y2 = x2 * r2.x - x3 * r2.y, y3 = x3 * r2.x + x2 * r2.y;
          x0 = y0; x1 = y1; x2 = y2; x3 = y3;
        }
        *reinterpret_cast<uint2*>(reinterpret_cast<u16*>(ws + O_GVC) + (size_t)R * 256 + lane * 4) = gvr[rr];
        u16* dst = reinterpret_cast<u16*>(ws + O_GKN) + (size_t)R * 256 + hd * 128;
        dst[i] = f2bf(x0); dst[i + 32] = f2bf(x1); dst[64 + i] = f2bf(x2); dst[96 + i] = f2bf(x3);
        if (lane < 32) {
          const int ki = lane & 15, kb = (lane >> 4) * 32;
          const float a1 = bf2f(kr[rr][0]), a2 = bf2f(kr[rr][1]);
          float o1 = a1, o2 = a2;
          if (lat) {
            const float2 csn = reinterpret_cast<const float2*>(ws + O_ROPEM)[((lane >> 4) ? (tt & 63) : (tt >> 6)) * 16 + ki];
            o1 = a1 * csn.x - a2 * csn.y; o2 = a2 * csn.x + a1 * csn.y;
          }
          u16* KPE = reinterpret_cast<u16*>(ws + O_KPE) + (size_t)R * 64;
          KPE[kb + ki] = f2bf(o1); KPE[kb + 16 + ki] = f2bf(o2);
        } else if (lane < 48) {
          const int j = lane - 32;
          const float raw = bf2f(br[rr]);
          if (j < 8) {
            reinterpret_cast<float*>(ws + O_BETA)[(size_t)R * 8 + j] = sigmf(raw);
          } else {
            const int jj = j - 8;
            const float xx = raw + p.in[16][l * 8 + jj];
            const float sp = fmaxf(xx, 0.f) + log1pf(__expf(-fabsf(xx)));
            reinterpret_cast<float*>(ws + O_GG)[(size_t)R * 8 + jj] = -__expf(p.in[15][l * 8 + jj]) * sp;
          }
        }
      }
    }
  }
}

__device__ __forceinline__ void phase_qnorm(const P& p, int l) {
  unsigned char* ws = p.ws;
  const u16* __restrict__ PROJ = reinterpret_cast<const u16*>(ws + O_PROJ);
  const int t = tid(), lane = t & 63, w = __builtin_amdgcn_readfirstlane(t >> 6);
  for (int rg = blockIdx.x * 8 + w; rg < 1152; rg += gridDim.x * 8) {
    const int R0 = rg * 8;
    const int b = R0 / TPB, tt0 = R0 - b * TPB;
    const bool lat = tt0 < 2048;
    {
      int hq = lane >> 3, i4 = (lane & 7) * 4;
      asm volatile("" : "+v"(hq), "+v"(i4));
      const float* g = p.in[12] + l * 128;
      float gs[4][4];
#pragma unroll
      for (int k = 0; k < 4; ++k) { const float4 gv = *reinterpret_cast<const float4*>(g + 32 * k + i4); gs[k][0] = gv.x; gs[k][1] = gv.y; gs[k][2] = gv.z; gs[k][3] = gv.w; }
      const float4* tg4 = reinterpret_cast<const float4*>(ws + O_ROPEG);
      u16* GQN = reinterpret_cast<u16*>(ws + O_GQN);
#pragma unroll 1
      for (int hb = 0; hb < 8; hb += 4) {
      uint2 xr[4][4];
#pragma unroll
      for (int rr = 0; rr < 4; ++rr)
#pragma unroll
        for (int k = 0; k < 4; ++k) xr[rr][k] = *reinterpret_cast<const uint2*>(PROJ + (size_t)(R0 + hb + rr) * DINP + C_GQ + hq * 128 + 32 * k + i4);
#pragma unroll
      for (int rr = 0; rr < 4; ++rr) {
        const int R = R0 + hb + rr, tt = tt0 + hb + rr;
        float a[4][4];
        float ss = 0.f;
#pragma unroll
        for (int k = 0; k < 4; ++k) {
          a[k][0] = bflo(xr[rr][k].x); a[k][1] = bfhi(xr[rr][k].x); a[k][2] = bflo(xr[rr][k].y); a[k][3] = bfhi(xr[rr][k].y);
#pragma unroll
          for (int j = 0; j < 4; ++j) ss += a[k][j] * a[k][j];
        }
        ss += __shfl_xor(ss, 1); ss += __shfl_xor(ss, 2); ss += __shfl_xor(ss, 4);
        const float rs = rsqrtf(ss * (1.f / 128.f) + EPS);
#pragma unroll
        for (int k = 0; k < 4; ++k)
#pragma unroll
          for (int j = 0; j < 4; ++j) a[k][j] *= rs * gs[k][j];
        if (lat) {
#pragma unroll
          for (int pr = 0; pr < 2; ++pr) {
            const int pos = pr ? (tt & 63) : (tt >> 6);
            const float4 t0 = tg4[(pos * 32 + i4) >> 1], t1 = tg4[((pos * 32 + i4) >> 1) + 1];
            const float cs[4] = {t0.x, t0.z, t1.x, t1.z}, sn[4] = {t0.y, t0.w, t1.y, t1.w};
#pragma unroll
            for (int j = 0; j < 4; ++j) {
              const float x1 = a[2 * pr][j], x2 = a[2 * pr + 1][j];
              a[2 * pr][j] = x1 * cs[j] - x2 * sn[j];
              a[2 * pr + 1][j] = x2 * cs[j] + x1 * sn[j];
            }
          }
        }
#pragma unroll
        for (int k = 0; k < 4; ++k) {
          uint2 o; o.x = pack2(a[k][0], a[k][1]); o.y = pack2(a[k][2], a[k][3]);
          *reinterpret_cast<uint2*>(GQN + (size_t)R * 1024 + hq * 128 + 32 * k + i4) = o;
        }
      }
      }
    }
  }
}

__device__ __forceinline__ void gdn_prep_item(const P& p, int pid, unsigned char* lds) {
  unsigned char* ws = p.ws;
  const int n = pid % 36; int r = pid / 36;
  const int h = r & 3; r >>= 2;
  const int dir = r & 1; const int b = r >> 1;
  const int Rb = b * TPB + n * 64;
  const int t = tid(), lane = t & 63, w = t >> 6, hf = lane >> 5, l31 = lane & 31;
  unsigned char* sK = lds;
  unsigned char* sQ = lds + 16384;
  unsigned char* sV = lds + 32768;
  float* sA = reinterpret_cast<float*>(lds + 49152);
  float* sgc = reinterpret_cast<float*>(lds + 65536);
  float* sbt = sgc + 64;
  float* sg = sbt + 64;
  const u16* GQ = reinterpret_cast<const u16*>(ws + O_GDQ);
  const u16* GK = reinterpret_cast<const u16*>(ws + O_GDK);
  const u16* GV = reinterpret_cast<const u16*>(ws + O_GDV);
#pragma unroll
  for (int i = 0; i < 2; ++i) {
    const int id = t + 512 * i;
    const int row = id >> 4, c = id & 15;
    const int R = Rb + (dir ? 63 - row : row);
    const size_t go = (size_t)R * 512 + h * 128 + c * 8;
    uint4 kq = *reinterpret_cast<const uint4*>(GK + go);
    uint4 qq = *reinterpret_cast<const uint4*>(GQ + go);
    uint4 vq = *reinterpret_cast<const uint4*>(GV + go);
    const int so = row * 256 + ((c ^ (row & 7)) << 4);
    *reinterpret_cast<uint4*>(sK + so) = kq;
    *reinterpret_cast<uint4*>(sQ + so) = qq;
    *reinterpret_cast<uint4*>(sV + row * 256 + c * 16) = vq;
  }
  if (t < 64) {
    const int R = Rb + (dir ? 63 - t : t);
    sg[t] = reinterpret_cast<const float*>(ws + O_GG)[(size_t)R * 8 + dir * 4 + h];
    sbt[t] = reinterpret_cast<const float*>(ws + O_BETA)[(size_t)R * 8 + dir * 4 + h];
  }
  __syncthreads();
  if (t < 64) {
    float s = sg[t];
#pragma unroll
    for (int o = 1; o < 64; o <<= 1) { const float v = __shfl_up(s, o); if (t >= o) s += v; }
    sgc[t] = s;
  }
  __syncthreads();
  {
    const int wt = w & 3, it = wt >> 1, jt = wt & 1;
    const unsigned char* sX = (w < 4) ? sK : sQ;
    f32x16 acc;
#pragma unroll
    for (int i = 0; i < 16; ++i) acc[i] = 0.f;
#pragma unroll
    for (int ks = 0; ks < 8; ++ks) {
      const int c = ks * 2 + hf;
      const int ra = it * 32 + l31, rb = jt * 32 + l31;
      bf16x8 a = ldsfrag(sX + ra * 256 + ((c ^ (ra & 7)) << 4));
      bf16x8 bb = ldsfrag(sK + rb * 256 + ((c ^ (rb & 7)) << 4));
      acc = mfma(a, bb, acc);
    }
    const int cj = jt * 32 + l31;
    const float gcc = sgc[cj];
    u16* QKD = reinterpret_cast<u16*>(ws + O_PQKD) + (size_t)pid * 4096;
#pragma unroll
    for (int x = 0; x < 16; ++x) {
      const int ri = it * 32 + 8 * (x >> 2) + 4 * hf + (x & 3);
      if (w < 4) {
        const float dec = __expf(fminf(gcc - sgc[ri], 0.f));
        sA[ri * 64 + cj] = (cj > ri) ? sbt[cj] * acc[x] * dec : 0.f;
      } else {
        const float dec = __expf(fminf(sgc[ri] - gcc, 0.f));
        QKD[ri * 64 + cj] = f2bf((ri >= cj) ? acc[x] * dec : 0.f);
      }
    }
  }
  __syncthreads();
  if (t < 256) {
    const int c = t;
    const bool isu = c < 128;
    const int d = c & 127;
    float* sX = reinterpret_cast<float*>(lds + 69632);
    float* U = reinterpret_cast<float*>(ws + O_PU) + (size_t)pid * 8192;
    u16* NW = reinterpret_cast<u16*>(ws + O_PNW) + (size_t)pid * 8192;
#pragma unroll 1
    for (int B = 0; B < 4; ++B) {
      const int i0 = B * 16;
      float s[16];
#pragma unroll
      for (int r = 0; r < 16; ++r) {
        const int i = i0 + r;
        if (isu) s[r] = bf2f(*reinterpret_cast<const u16*>(sV + i * 256 + d * 2)) * sbt[i];
        else s[r] = bf2f(*reinterpret_cast<const u16*>(sK + i * 256 + (((d >> 3) ^ (i & 7)) << 4) + (d & 7) * 2)) * sbt[i] * __expf(sgc[i]);
      }
#pragma unroll 1
      for (int j = 0; j < i0; j += 4) {
        float xj[4]; float4 av[4][4];
#pragma unroll
        for (int u = 0; u < 4; ++u) {
          xj[u] = sX[(j + u) * 256 + c];
          const float4* ap = reinterpret_cast<const float4*>(sA + (j + u) * 64 + i0);
          av[u][0] = ap[0]; av[u][1] = ap[1]; av[u][2] = ap[2]; av[u][3] = ap[3];
        }
        __builtin_amdgcn_sched_barrier(0);
#pragma unroll
        for (int u = 0; u < 4; ++u) {
          const float nx = -xj[u];
          s[0] = __builtin_fmaf(av[u][0].x, nx, s[0]); s[1] = __builtin_fmaf(av[u][0].y, nx, s[1]); s[2] = __builtin_fmaf(av[u][0].z, nx, s[2]); s[3] = __builtin_fmaf(av[u][0].w, nx, s[3]);
          s[4] = __builtin_fmaf(av[u][1].x, nx, s[4]); s[5] = __builtin_fmaf(av[u][1].y, nx, s[5]); s[6] = __builtin_fmaf(av[u][1].z, nx, s[6]); s[7] = __builtin_fmaf(av[u][1].w, nx, s[7]);
          s[8] = __builtin_fmaf(av[u][2].x, nx, s[8]); s[9] = __builtin_fmaf(av[u][2].y, nx, s[9]); s[10] = __builtin_fmaf(av[u][2].z, nx, s[10]); s[11] = __builtin_fmaf(av[u][2].w, nx, s[11]);
          s[12] = __builtin_fmaf(av[u][3].x, nx, s[12]); s[13] = __builtin_fmaf(av[u][3].y, nx, s[13]); s[14] = __builtin_fmaf(av[u][3].z, nx, s[14]); s[15] = __builtin_fmaf(av[u][3].w, nx, s[15]);
        }
        __builtin_amdgcn_sched_barrier(0);
      }
#pragma unroll
      for (int rp = 0; rp < 15; ++rp) {
        const float4* ap = reinterpret_cast<const float4*>(sA + (i0 + rp) * 64 + i0);
        const float4 a0 = ap[0], a1 = ap[1], a2 = ap[2], a3 = ap[3];
        const float av[16] = {a0.x, a0.y, a0.z, a0.w, a1.x, a1.y, a1.z, a1.w, a2.x, a2.y, a2.z, a2.w, a3.x, a3.y, a3.z, a3.w};
#pragma unroll
        for (int r = rp + 1; r < 16; ++r) s[r] -= av[r] * s[rp];
      }
#pragma unroll
      for (int r = 0; r < 16; ++r) {
        sX[(i0 + r) * 256 + c] = s[r];
        if (isu) U[(i0 + r) * 128 + d] = s[r];
        else NW[(i0 + r) * 128 + d] = f2bf(-s[r]);
      }
    }
  } else {
    const int tq = t - 256;
    u16* QT = reinterpret_cast<u16*>(ws + O_PQT) + (size_t)pid * 8192;
    u16* KTT = reinterpret_cast<u16*>(ws + O_PKTT) + (size_t)pid * 8192;
    const float gl = sgc[63];
    for (int rr = 0; rr < 32; ++rr) {
      const int idx = tq + 256 * rr;
      {
        const int i = idx >> 7, d = idx & 127;
        float q = bf2f(*reinterpret_cast<const u16*>(sQ + i * 256 + (((d >> 3) ^ (i & 7)) << 4) + (d & 7) * 2));
        QT[i * 128 + d] = f2bf(q * __expf(sgc[i]));
      }
      {
        const int i = idx & 63, d = idx >> 6;
        float k = bf2f(*reinterpret_cast<const u16*>(sK + i * 256 + (((d >> 3) ^ (i & 7)) << 4) + (d & 7) * 2));
        KTT[d * 64 + i] = f2bf(k * __expf(gl - sgc[i]));
      }
    }
    if (tq == 0) reinterpret_cast<float*>(ws + O_PEGL)[pid] = __expf(gl);
  }
  __syncthreads();
}

__device__ __forceinline__ int scan_chunk(int dir, int step) { return dir ? 35 - step : (step < 4 ? 32 + step : step - 4); }
__device__ __forceinline__ void gdn_scan_item(const P& p, int item, unsigned char* lds) {
  unsigned char* ws = p.ws;
  const int h = item & 3, dir = (item >> 2) & 1, b = item >> 3;
  const int t = tid(), lane = t & 63, w = t >> 6, hf = lane >> 5, l31 = lane & 31;
  unsigned char* sST = lds;
  unsigned char* sVN = lds + 32768;
  unsigned char* sNW = lds + 49152;
  unsigned char* sQT = lds + 65536;
  unsigned char* sKT = lds + 81920;
  unsigned char* sQK = lds + 98304;
  float* sU = reinterpret_cast<float*>(lds + 106496);
  const float* Uall = reinterpret_cast<const float*>(ws + O_PU);
  const u16* NWall = reinterpret_cast<const u16*>(ws + O_PNW);
  const u16* QTall = reinterpret_cast<const u16*>(ws + O_PQT);
  const u16* KTTall = reinterpret_cast<const u16*>(ws + O_PKTT);
  const u16* QKDall = reinterpret_cast<const u16*>(ws + O_PQKD);
  const float* EGL = reinterpret_cast<const float*>(ws + O_PEGL);
  float* OUT = reinterpret_cast<float*>(ws + (dir ? O_OB : O_OF));
  const int pid0 = ((b * 2 + dir) * 4 + h) * 36;
  u32x4 rg[11];
  int so[11];
#pragma unroll
  for (int i = 0; i < 2; ++i) { const int id = t + 512 * i, row = id >> 4, ch = id & 15; so[i] = 49152 + row * 256 + ((ch ^ (row & 7)) << 4); so[2 + i] = 65536 + row * 256 + ((ch ^ (row & 7)) << 4); }
#pragma unroll
  for (int i = 0; i < 2; ++i) { const int id = t + 512 * i, row = id >> 3, ch = id & 7; so[4 + i] = 81920 + row * 128 + ((ch ^ (row & 7)) << 4); }
  { const int row = t >> 3, ch = t & 7; so[6] = 98304 + row * 128 + ((ch ^ (row & 7)) << 4); }
#pragma unroll
  for (int i = 0; i < 4; ++i) so[7 + i] = 106496 + (t + 512 * i) * 16;
#define SCAN_GLOAD(pid)                                                                              \
  {                                                                                                   \
    const u32x4* g0 = reinterpret_cast<const u32x4*>(NWall + (size_t)(pid) * 8192);                  \
    const u32x4* g1 = reinterpret_cast<const u32x4*>(QTall + (size_t)(pid) * 8192);                  \
    const u32x4* g2 = reinterpret_cast<const u32x4*>(KTTall + (size_t)(pid) * 8192);                 \
    const u32x4* g3 = reinterpret_cast<const u32x4*>(QKDall + (size_t)(pid) * 4096);                 \
    const u32x4* g4 = reinterpret_cast<const u32x4*>(Uall + (size_t)(pid) * 8192);                   \
    rg[0] = g0[t]; rg[1] = g0[t + 512]; rg[2] = g1[t]; rg[3] = g1[t + 512]; rg[4] = g2[t]; rg[5] = g2[t + 512]; \
    rg[6] = g3[t]; rg[7] = g4[t]; rg[8] = g4[t + 512]; rg[9] = g4[t + 1024]; rg[10] = g4[t + 1536];   \
  }
#define SCAN_SWRITE() { _Pragma("unroll") for (int i = 0; i < 11; ++i) *reinterpret_cast<u32x4*>(lds + so[i]) = rg[i]; }
  SCAN_GLOAD(pid0 + scan_chunk(dir, 0))
  float egl = EGL[pid0 + scan_chunk(dir, 0)];
  for (int i = t; i < 32768 / 16; i += NTHR) reinterpret_cast<uint4*>(sST)[i] = make_uint4(0, 0, 0, 0);
  SCAN_SWRITE()
  f32x16 accS[2];
#pragma unroll
  for (int a = 0; a < 2; ++a)
#pragma unroll
    for (int i = 0; i < 16; ++i) accS[a][i] = 0.f;
  const int ct = w >> 2, et = w & 3;
  const int dt = w & 3, ep = (w >> 2) * 2;
  const int arow = ct * 32 + l31;
  const int krow = dt * 32 + l31;
  const int erow = et * 32 + l31;
  __syncthreads();
  for (int step = 0; step < 36; ++step) {
    const int n = scan_chunk(dir, step);
    const int nn = scan_chunk(dir, step < 35 ? step + 1 : 35);
    const int Rb = b * TPB + n * 64;
    SCAN_GLOAD(pid0 + nn)
    const float egl_next = EGL[pid0 + nn];
    {
      f32x16 acc;
#pragma unroll
      for (int x = 0; x < 16; ++x) {
        const int c = ct * 32 + 8 * (x >> 2) + 4 * hf + (x & 3);
        acc[x] = sU[c * 128 + et * 32 + l31];
      }
#pragma unroll
      for (int ks = 0; ks < 8; ++ks) {
        const int c = ks * 2 + hf;
        bf16x8 a = ldsfrag(sNW + arow * 256 + ((c ^ (arow & 7)) << 4));
        bf16x8 bb = ldsfrag(sST + erow * 256 + ((c ^ (erow & 7)) << 4));
        acc = mfma(a, bb, acc);
      }
#pragma unroll
      for (int g = 0; g < 4; ++g) {
        const int q = ct * 4 + g;
        uint2 v; v.x = pack2(acc[4 * g], acc[4 * g + 1]); v.y = pack2(acc[4 * g + 2], acc[4 * g + 3]);
        *reinterpret_cast<uint2*>(sVN + erow * 128 + ((q ^ (erow & 7)) << 4) + hf * 8) = v;
      }
    }
    __syncthreads();
    {
      f32x16 acc;
#pragma unroll
      for (int x = 0; x < 16; ++x) acc[x] = 0.f;
#pragma unroll
      for (int ks = 0; ks < 8; ++ks) {
        const int c = ks * 2 + hf;
        bf16x8 a = ldsfrag(sQT + arow * 256 + ((c ^ (arow & 7)) << 4));
        bf16x8 bb = ldsfrag(sST + erow * 256 + ((c ^ (erow & 7)) << 4));
        acc = mfma(a, bb, acc);
      }
#pragma unroll
      for (int ks = 0; ks < 4; ++ks) {
        const int c = ks * 2 + hf;
        bf16x8 a = ldsfrag(sQK + arow * 128 + ((c ^ (arow & 7)) << 4));
        bf16x8 bb = ldsfrag(sVN + erow * 128 + ((c ^ (erow & 7)) << 4));
        acc = mfma(a, bb, acc);
      }
#pragma unroll
      for (int x = 0; x < 16; ++x) {
        const int c = ct * 32 + 8 * (x >> 2) + 4 * hf + (x & 3);
        const int R = Rb + (dir ? 63 - c : c);
        OUT[(size_t)R * 512 + h * 128 + et * 32 + l31] = acc[x];
      }
    }
#pragma unroll
    for (int a = 0; a < 2; ++a) {
      const int er = (ep + a) * 32 + l31;
#pragma unroll
      for (int x = 0; x < 16; ++x) accS[a][x] *= egl;
#pragma unroll
      for (int ks = 0; ks < 4; ++ks) {
        const int c = ks * 2 + hf;
        bf16x8 ka = ldsfrag(sKT + krow * 128 + ((c ^ (krow & 7)) << 4));
        bf16x8 bb = ldsfrag(sVN + er * 128 + ((c ^ (er & 7)) << 4));
        accS[a] = mfma(ka, bb, accS[a]);
      }
    }
    __syncthreads();
#pragma unroll
    for (int a = 0; a < 2; ++a) {
      const int er = (ep + a) * 32 + l31;
#pragma unroll
      for (int g = 0; g < 4; ++g) {
        const int q = dt * 4 + g;
        uint2 v; v.x = pack2(accS[a][4 * g], accS[a][4 * g + 1]); v.y = pack2(accS[a][4 * g + 2], accS[a][4 * g + 3]);
        *reinterpret_cast<uint2*>(sST + er * 256 + ((q ^ (er & 7)) << 4) + hf * 8) = v;
      }
    }
    SCAN_SWRITE()
    egl = egl_next;
    __syncthreads();
  }
#undef SCAN_GLOAD
#undef SCAN_SWRITE
}

template <int DQK>
__device__ __forceinline__ uint4 att_kload(int i, int t, int krow0, const u16* k1, int k1s, const u16* kpe) {
  constexpr int CH = DQK / 8;
  const int id = t + 512 * i;
  const int key = id / CH, c = id - key * CH;
  const unsigned kr = (unsigned)(krow0 + key);
  const u16* src = k1 + (kr * (unsigned)k1s + (unsigned)c * 8u);
  if (DQK == 192) { if (c >= 16) src = kpe + (kr * 64u + (unsigned)(c - 16) * 8u); }
  return *reinterpret_cast<const uint4*>(src);
}
template <int DQK>
__device__ __forceinline__ void att_kstore(int i, int t, unsigned char* sK, uint4 v) {
  constexpr int CH = DQK / 8;
  const int id = t + 512 * i;
  const int key = id / CH, c = id - key * CH;
  const int sw = (DQK == 192) ? ((key >> 1) & 7) : (key & 15);
  *reinterpret_cast<uint4*>(sK + key * (DQK * 2) + ((c ^ sw) << 4)) = v;
}
__device__ __forceinline__ uint4 att_vload(int i, int t, int krow0, const u16* vsrc, int vs) {
  const int id = t + 512 * i;
  const int key = id >> 4, ch = id & 15;
  return *reinterpret_cast<const uint4*>(vsrc + ((unsigned)(krow0 + key) * (unsigned)vs + (unsigned)ch * 8u));
}
__device__ __forceinline__ void att_vstore(int i, int t, unsigned char* sV, uint4 v) {
  const int id = t + 512 * i;
  const int key = id >> 4, ch = id & 15;
  *reinterpret_cast<uint4*>(sV + 256 * key + 16 * (ch ^ (((key & 3) << 2) | ((key >> 2) & 3)))) = v;
}

template <int DQK>
__device__ __forceinline__ void attn_item(const P& p, int l, int b, int h, int qb, unsigned char* lds) {
  constexpr bool MLA = (DQK == 192);
  constexpr int KS = DQK / 16;
  constexpr int CH = DQK / 8;
  constexpr int KLD = CH * 64 / 512;
  unsigned char* ws = p.ws;
  const int t = tid(), lane = t & 63, w = t >> 6, hf = lane >> 5, l31 = lane & 31;
  const u16* PROJ = reinterpret_cast<const u16*>(ws + O_PROJ);
  const int rb = b * TPB;
  const bool lat = qb < 8;
  const int qrow = rb + (lat ? qb * 256 : 2048) + w * 32 + l31;
  const int kbase = lat ? rb : rb + 2048;
  const int ntile = lat ? 36 : 4;
  const int kvh = h >> 2;
  const u16* qsrc; const u16* k1; int k1s; const u16* vsrc; int vs; u16* odst; int os;
  if (MLA) {
    qsrc = reinterpret_cast<const u16*>(ws + O_QRAW) + (size_t)qrow * 768 + h * 192;
    k1 = reinterpret_cast<const u16*>(ws + O_KVRAW) + h * 256; k1s = 1024;
    vsrc = reinterpret_cast<const u16*>(ws + O_KVRAW) + h * 256 + 128; vs = 1024;
    odst = reinterpret_cast<u16*>(ws + O_OA) + (size_t)qrow * 512 + h * 128; os = 512;
  } else {
    qsrc = PROJ + (size_t)qrow * DINP + C_GQ + h * 128;
    k1 = reinterpret_cast<const u16*>(ws + O_GKN) + kvh * 128; k1s = 256;
    vsrc = reinterpret_cast<const u16*>(ws + O_GVC) + kvh * 128; vs = 256;
    odst = reinterpret_cast<u16*>(ws + O_OBQ) + (size_t)qrow * 1024 + h * 128; os = 1024;
  }
  (void)os;
  const u16* kpe = reinterpret_cast<const u16*>(ws + O_KPE);
  const float sc = (MLA ? 0.07216878364870322f : 0.08838834764831845f) * 1.4426950408889634f;
  bf16x8 qf[KS];
  {
    const int tq = (qrow - rb);
    const int prow = tq >> 6, pcol = tq & 63;
    if (MLA) {
      const float2* tm = reinterpret_cast<const float2*>(ws + O_ROPEM);
#pragma unroll
      for (int ks = 0; ks < 8; ++ks) qf[ks] = asfrag(*reinterpret_cast<const uint4*>(qsrc + ks * 16 + hf * 8));
#pragma unroll
      for (int pr = 0; pr < 2; ++pr) {
        uint4 va = *reinterpret_cast<const uint4*>(qsrc + (8 + 2 * pr) * 16 + hf * 8);
        uint4 vb = *reinterpret_cast<const uint4*>(qsrc + (9 + 2 * pr) * 16 + hf * 8);
        float xa[8] = {bflo(va.x), bfhi(va.x), bflo(va.y), bfhi(va.y), bflo(va.z), bfhi(va.z), bflo(va.w), bfhi(va.w)};
        float xb[8] = {bflo(vb.x), bfhi(vb.x), bflo(vb.y), bfhi(vb.y), bflo(vb.z), bfhi(vb.z), bflo(vb.w), bfhi(vb.w)};
        if (lat) {
          const int pos = pr ? pcol : prow;
#pragma unroll
          for (int j = 0; j < 8; ++j) {
            const float2 csn = tm[pos * 16 + 8 * hf + j];
            const float o1 = xa[j] * csn.x - xb[j] * csn.y, o2 = xb[j] * csn.x + xa[j] * csn.y;
            xa[j] = o1; xb[j] = o2;
          }
        }
        uint4 oa, ob;
        oa.x = pack2(xa[0], xa[1]); oa.y = pack2(xa[2], xa[3]); oa.z = pack2(xa[4], xa[5]); oa.w = pack2(xa[6], xa[7]);
        ob.x = pack2(xb[0], xb[1]); ob.y = pack2(xb[2], xb[3]); ob.z = pack2(xb[4], xb[5]); ob.w = pack2(xb[6], xb[7]);
        qf[(DQK == 192) ? 8 + 2 * pr : 0] = asfrag(oa); qf[(DQK == 192) ? 9 + 2 * pr : 1] = asfrag(ob);
      }
    } else {
      const u16* gq = reinterpret_cast<const u16*>(ws + O_GQN) + (size_t)qrow * 1024 + h * 128;
#pragma unroll
      for (int ks = 0; ks < 8; ++ks) qf[ks] = asfrag(*reinterpret_cast<const uint4*>(gq + ks * 16 + hf * 8));
    }
  }
  f32x16 O[4];
#pragma unroll
  for (int a = 0; a < 4; ++a)
#pragma unroll
    for (int i = 0; i < 16; ++i) O[a][i] = 0.f;
  float mrun = -1e30f, lsum = 0.f;
  uint4 rk0, rk1, rk2 = make_uint4(0, 0, 0, 0), rv0, rv1;
  constexpr int STG = 64 * DQK * 2 + 16384;
  const int kbase_l = l31 * (DQK * 2);
  const int kxm = (hf ^ (MLA ? ((l31 >> 1) & 7) : (l31 & 15))) << 4;
  int vb2[2], vq6;
  {
    const int g = (lane >> 4) & 1, q = (lane & 15) >> 2, pp = lane & 3;
    const int basel = 256 * (4 * hf + q) + 8 * (pp & 1);
    vq6 = q << 6;
#pragma unroll
    for (int r2 = 0; r2 < 2; ++r2) {
      const int low2 = (2 * g + (pp >> 1)) ^ ((2 * r2 + hf) & 3);
      vb2[r2] = 64 * DQK * 2 + basel + 2048 * r2 + 16 * low2;
    }
  }
#define ATT_LOAD(kr0)                                                  \
  rk0 = att_kload<DQK>(0, t, (kr0), k1, k1s, kpe);                     \
  rk1 = att_kload<DQK>(1, t, (kr0), k1, k1s, kpe);                     \
  if (KLD > 2) rk2 = att_kload<DQK>(2, t, (kr0), k1, k1s, kpe);        \
  rv0 = att_vload(0, t, (kr0), vsrc, vs);                              \
  rv1 = att_vload(1, t, (kr0), vsrc, vs);
#define ATT_STORE(stg)                                                 \
  att_kstore<DQK>(0, t, (stg), rk0);                                   \
  att_kstore<DQK>(1, t, (stg), rk1);                                   \
  if (KLD > 2) att_kstore<DQK>(2, t, (stg), rk2);                      \
  att_vstore(0, t, (stg) + 64 * DQK * 2, rv0);                         \
  att_vstore(1, t, (stg) + 64 * DQK * 2, rv1);
  ATT_LOAD(kbase)
  ATT_STORE(lds)
  __syncthreads();
  for (int kt = 0; kt < ntile; ++kt) {
    const bool more = kt + 1 < ntile;
    unsigned char* cur = lds + (kt & 1) * STG;
    if (more) { ATT_LOAD(kbase + (kt + 1) * 64) }
    f32x16 st[2];
#pragma unroll
    for (int mt = 0; mt < 2; ++mt)
#pragma unroll
      for (int i = 0; i < 16; ++i) st[mt][i] = 0.f;
    {
      constexpr int NBM = KS / 4;
      constexpr int NBT = 2 * NBM;
      bf16x8 fr[2][4];
#define KFRAG(mt, ks) ldsfrag(cur + kbase_l + ((MLA ? (((ks) & 3) << 5) : ((((ks) >> 2) << 7) | (((ks) & 3) << 5))) ^ kxm) + (mt) * (32 * DQK * 2) + (MLA ? ((ks) >> 2) * 128 : 0))
#pragma unroll
      for (int i = 0; i < 4; ++i) fr[0][i] = KFRAG(0, i);
      __builtin_amdgcn_sched_barrier(0);
#pragma unroll
      for (int q = 0; q < NBT; ++q) {
        if (q + 1 < NBT) {
          const int mtn = (q + 1) / NBM, k0n = ((q + 1) % NBM) * 4;
#pragma unroll
          for (int i = 0; i < 4; ++i) fr[(q + 1) & 1][i] = KFRAG(mtn, k0n + i);
        }
        const int mtc = q / NBM, k0c = (q % NBM) * 4;
#pragma unroll
        for (int i = 0; i < 4; ++i) st[mtc] = mfma(fr[q & 1][i], qf[k0c + i], st[mtc]);
        __builtin_amdgcn_sched_barrier(0);
      }
#undef KFRAG
    }
    float mx = -1e30f;
#pragma unroll
    for (int mt = 0; mt < 2; ++mt)
#pragma unroll
      for (int i = 0; i < 16; ++i) mx = fmaxf(mx, st[mt][i]);
    mx = fmaxf(mx, __shfl_xor(mx, 32));
    const float mnew = fmaxf(mrun, mx * sc);
    if (__builtin_amdgcn_ballot_w64(mnew > mrun) != 0ull) {
      const float alpha = __builtin_amdgcn_exp2f(mrun - mnew);
      lsum *= alpha;
#pragma unroll
      for (int a = 0; a < 4; ++a)
#pragma unroll
        for (int i = 0; i < 16; ++i) O[a][i] *= alpha;
    }
    mrun = mnew;
    float ps = 0.f;
#pragma unroll
    for (int mt = 0; mt < 2; ++mt)
#pragma unroll
      for (int i = 0; i < 16; ++i) {
        const float pv = __builtin_amdgcn_exp2f(st[mt][i] * sc - mnew);
        st[mt][i] = pv; ps += pv;
      }
    lsum += ps;
    const LAS unsigned char* curl = (const LAS unsigned char*)cur;
    {
      v8s va[4], vb[4];
#define VFRAG(dst, s_)                                                                                                 \
      _Pragma("unroll") for (int et = 0; et < 4; ++et) {                                                               \
        const v4s lo = __builtin_amdgcn_ds_read_tr16_b64_v4i16((LAS v4s*)(curl + vb2[0] + ((et << 6) ^ vq6) + 4096 * (s_)));         \
        const v4s hi = __builtin_amdgcn_ds_read_tr16_b64_v4i16((LAS v4s*)(curl + vb2[1] + ((et << 6) ^ vq6) + 4096 * (s_)));         \
        dst[et] = __builtin_shufflevector(lo, hi, 0, 1, 2, 3, 4, 5, 6, 7);                                             \
      }
#define PVMMA(src, s_)                                                                                                 \
      {                                                                                                                \
        uint4 pk;                                                                                                      \
        const int mt = (s_) >> 1, o8 = 8 * ((s_) & 1);                                                                 \
        pk.x = pack2(st[mt][o8 + 0], st[mt][o8 + 1]); pk.y = pack2(st[mt][o8 + 2], st[mt][o8 + 3]);                    \
        pk.z = pack2(st[mt][o8 + 4], st[mt][o8 + 5]); pk.w = pack2(st[mt][o8 + 6], st[mt][o8 + 7]);                    \
        const bf16x8 pf = asfrag(pk);                                                                                  \
        _Pragma("unroll") for (int et = 0; et < 4; ++et) O[et] = mfma(__builtin_bit_cast(bf16x8, src[et]), pf, O[et]); \
      }
      VFRAG(va, 0)
      __builtin_amdgcn_sched_barrier(0);
      VFRAG(vb, 1)
      PVMMA(va, 0)
      __builtin_amdgcn_sched_barrier(0);
      VFRAG(va, 2)
      PVMMA(vb, 1)
      __builtin_amdgcn_sched_barrier(0);
      VFRAG(vb, 3)
      PVMMA(va, 2)
      __builtin_amdgcn_sched_barrier(0);
      PVMMA(vb, 3)
#undef VFRAG
#undef PVMMA
    }
    if (more) { ATT_STORE(lds + ((kt + 1) & 1) * STG) }
    __syncthreads();
  }
#undef ATT_LOAD
#undef ATT_STORE
  lsum += __shfl_xor(lsum, 32);
  const float inv = 1.f / lsum;
#pragma unroll
  for (int et = 0; et < 4; ++et)
#pragma unroll
    for (int g = 0; g < 4; ++g) {
      const int e0 = et * 32 + 8 * g + 4 * hf;
      uint2 o;
      o.x = pack2(O[et][4 * g] * inv, O[et][4 * g + 1] * inv);
      o.y = pack2(O[et][4 * g + 2] * inv, O[et][4 * g + 3] * inv);
      *reinterpret_cast<uint2*>(odst + e0) = o;
    }
  __syncthreads();
}

__device__ __forceinline__ void phase_mixers(const P& p, int l, unsigned char* lds, int* sitem, int cidx, int only = 0) {
  int* ctr = reinterpret_cast<int*>(p.ws + O_CTR) + cidx;
  const int nscan = 32, nmla = 128, ngqa = 256;
  const int nctx = (l == 0) ? 48 : 0;
  const int total = nscan + nmla + ngqa + nctx;
  for (;;) {
    if (threadIdx.x == 0) *sitem = atomicAdd(ctr, 1);
    __syncthreads();
    int it = *sitem;
    __syncthreads();
    if (it >= total) break;
    if (only == 1 && it >= nscan) break;
    if (only == 2 && (it < nscan + nmla || it >= nscan + nmla + ngqa)) continue;
    if (only == 3 && (it < nscan || it >= nscan + nmla)) continue;
    if (it < nscan) { gdn_scan_item(p, it, lds); __syncthreads(); continue; }
    it -= nscan;
    int typ, b, h, qb;
    if (it < nmla) { typ = 0; b = it >> 5; h = (it >> 3) & 3; qb = it & 7; }
    else if (it < nmla + ngqa) { it -= nmla; typ = 1; b = it >> 6; h = (it >> 3) & 7; qb = it & 7; }
    else if (it < nmla + ngqa + 16) { it -= nmla + ngqa; typ = 0; b = it >> 2; h = it & 3; qb = 8; }
    else { it -= nmla + ngqa + 16; typ = 1; b = it >> 3; h = it & 7; qb = 8; }
    if (typ == 0) attn_item<192>(p, l, b, h, qb, lds);
    else attn_item<128>(p, l, b, h, qb, lds);
  }
}

__device__ __forceinline__ void phase_gdn_out(const P& p, int l) {
  unsigned char* ws = p.ws;
  const int t = tid(), lane = t & 63, w = t >> 6;
  const float* __restrict__ OF = reinterpret_cast<const float*>(ws + O_OF);
  const float* __restrict__ OB = reinterpret_cast<const float*>(ws + O_OB);
  const u16* __restrict__ PROJ = reinterpret_cast<const u16*>(ws + O_PROJ);
  u16* OC = reinterpret_cast<u16*>(ws + O_OC);
  const float* g = p.in[17] + l * 128 + (lane & 15) * 8;
  const float4 ga = *reinterpret_cast<const float4*>(g), gb = *reinterpret_cast<const float4*>(g + 4);
  const float gg[8] = {ga.x, ga.y, ga.z, ga.w, gb.x, gb.y, gb.z, gb.w};
  const int nrow = (l == 1) ? 8192 : MROWS;
  for (int q0 = (blockIdx.x * 8 + w) * 2; q0 < nrow; q0 += gridDim.x * 16) {
    float4 fa[2][2], fb[2][2]; uint4 og[2]; int Rr[2];
#pragma unroll
    for (int u = 0; u < 2; ++u) {
      const int q = q0 + u;
      const int R = (l == 1) ? ((q >> 11) * TPB + (q & 2047)) : q;
      Rr[u] = R;
      const size_t o = (size_t)R * 512 + lane * 8;
      fa[u][0] = *reinterpret_cast<const float4*>(OF + o); fa[u][1] = *reinterpret_cast<const float4*>(OF + o + 4);
      fb[u][0] = *reinterpret_cast<const float4*>(OB + o); fb[u][1] = *reinterpret_cast<const float4*>(OB + o + 4);
      og[u] = *reinterpret_cast<const uint4*>(PROJ + (size_t)R * DINP + C_OG + lane * 8);
    }
#pragma unroll
    for (int u = 0; u < 2; ++u) {
      float a[8] = {fa[u][0].x + fb[u][0].x, fa[u][0].y + fb[u][0].y, fa[u][0].z + fb[u][0].z, fa[u][0].w + fb[u][0].w,
                    fa[u][1].x + fb[u][1].x, fa[u][1].y + fb[u][1].y, fa[u][1].z + fb[u][1].z, fa[u][1].w + fb[u][1].w};
      float ss = 0.f;
#pragma unroll
      for (int j = 0; j < 8; ++j) ss += a[j] * a[j];
#pragma unroll
      for (int o = 8; o > 0; o >>= 1) ss += __shfl_xor(ss, o);
      const float rs = rsqrtf(ss * (1.f / 128.f) + EPS);
      float gt[8];
      unpack8(og[u], gt);
      uint4 o;
      o.x = pack2(a[0] * rs * gg[0] * siluf(gt[0]), a[1] * rs * gg[1] * siluf(gt[1]));
      o.y = pack2(a[2] * rs * gg[2] * siluf(gt[2]), a[3] * rs * gg[3] * siluf(gt[3]));
      o.z = pack2(a[4] * rs * gg[4] * siluf(gt[4]), a[5] * rs * gg[5] * siluf(gt[5]));
      o.w = pack2(a[6] * rs * gg[6] * siluf(gt[6]), a[7] * rs * gg[7] * siluf(gt[7]));
      *reinterpret_cast<uint4*>(OC + (size_t)Rr[u] * 512 + lane * 8) = o;
    }
  }
}

#define XB_TMO      128
#define XB_XCNT(j)  (256  + 64 * (j))
#define XB_XSUB(j)  (1280 + 64 * (j))
#define XB_XGEN(j)  (2304 + 64 * (j))
#define XB_TOP      3328
#define XB_TOPGEN   3392
#define XCD_BAR_WORDS 3456
#define XB_SPIN_CAP (1u << 18)
__device__ __forceinline__ unsigned xb_ld(unsigned* p)              { return __hip_atomic_load(p, __ATOMIC_RELAXED, __HIP_MEMORY_SCOPE_AGENT); }
__device__ __forceinline__ unsigned xb_add(unsigned* p, unsigned v) { return __hip_atomic_fetch_add(p, v, __ATOMIC_RELAXED, __HIP_MEMORY_SCOPE_AGENT); }
__device__ __forceinline__ unsigned xb_xcc_id() { return (unsigned)__builtin_amdgcn_s_getreg((3 << 11) | 20) & 0xFu; }
#define XB_SPIN(cond, bar) do { unsigned _sp = 0; while (cond) { __builtin_amdgcn_s_sleep(1); \
    if ((++_sp & 255u) == 0u) { if (xb_ld(&(bar)[XB_TMO])) break; if (_sp > XB_SPIN_CAP) { atomicAdd(&(bar)[XB_TMO], 1u); break; } } } } while (0)
struct XcdBarrier { unsigned* bar; unsigned x; volatile __attribute__((address_space(3))) unsigned* st; };
__device__ __forceinline__ XcdBarrier xcd_barrier_post(unsigned* bar, volatile __attribute__((address_space(3))) unsigned* st) {
  XcdBarrier b; b.bar = bar; b.x = xb_xcc_id(); b.st = st;
  if (threadIdx.x == 0) (void)xb_add(&bar[XB_XCNT(b.x)], 1u);
  return b;
}
__device__ __forceinline__ void xcd_barrier_complete(unsigned* bar, unsigned x, unsigned& nloc, unsigned& nx) {
  const unsigned G = gridDim.x * gridDim.y * gridDim.z;
  unsigned sum, cnt, mine, sp = 0u;
  for (;;) {
    sum = 0u; cnt = 0u; mine = 0u;
#pragma unroll
    for (unsigned j = 0; j < 16; ++j) { const unsigned c = xb_ld(&bar[XB_XCNT(j)]); sum += c; cnt += (c > 0u) ? 1u : 0u; mine = (j == x) ? c : mine; }
    if (sum == G) break;
    __builtin_amdgcn_s_sleep(1);
    if ((++sp & 255u) == 0u) { if (xb_ld(&bar[XB_TMO])) break; if (sp > XB_SPIN_CAP) { atomicAdd(&bar[XB_TMO], 1u); break; } }
  }
  nloc = mine > 0u ? mine : 1u; nx = cnt > 0u ? cnt : 1u;
}
__device__ __forceinline__ void xcd_barrier(const XcdBarrier& b) {
  asm volatile("s_waitcnt vmcnt(0)" ::: "memory");
  __syncthreads();
  if (threadIdx.x == 0) {
    unsigned* bar = b.bar;
    __builtin_amdgcn_s_waitcnt(0);
    unsigned nloc = b.st[0], nx = b.st[1];
    if (nloc == 0u) { xcd_barrier_complete(bar, b.x, nloc, nx); b.st[0] = nloc; b.st[1] = nx; }
    const unsigned old = xb_add(&bar[XB_XSUB(b.x)], 1u);
    const unsigned gen = old / nloc;
    if (old + 1u == (gen + 1u) * nloc) {
      __builtin_amdgcn_fence(__ATOMIC_RELEASE, "agent");
      asm volatile("s_waitcnt vmcnt(0)" ::: "memory");
      const unsigned og = xb_add(&bar[XB_TOP], 1u);
      const unsigned tg = og / nx;
      if (og + 1u == (tg + 1u) * nx) xb_add(&bar[XB_TOPGEN], 1u);
      else XB_SPIN(xb_ld(&bar[XB_TOPGEN]) == tg, bar);
      __builtin_amdgcn_fence(__ATOMIC_ACQUIRE, "agent");
      xb_add(&bar[XB_XGEN(b.x)], 1u);
      asm volatile("s_waitcnt vmcnt(0)" ::: "memory");
    } else {
      XB_SPIN(xb_ld(&bar[XB_XGEN(b.x)]) == gen, bar);
      __builtin_amdgcn_fence(__ATOMIC_ACQUIRE, "agent");
      asm volatile("s_waitcnt vmcnt(0)" ::: "memory");
    }
  }
  __syncthreads();
}

constexpr int NPHASE = 24 + ((PROBE == 1 || PROBE == 3 || PROBE == 2 || PROBE == 5 || PROBE == 6 || PROBE == 7 || PROBE == 8 || PROBE == 11 || PROBE == 12 || PROBE == 13) ? 2 : 0) + (PROBE == 4 ? 1 : 0) + (PROBE == 9 ? 10 : 0);

__global__ void __launch_bounds__(NTHR) mega(P p) {
  extern __shared__ __attribute__((aligned(16))) unsigned char lds[];
  float* sred = reinterpret_cast<float*>(lds + LDS_MAIN);
  int* sitem = reinterpret_cast<int*>(lds + LDS_MAIN + 64);
  unsigned char* ws = p.ws;
  int ph = 0;
  volatile __attribute__((address_space(3))) unsigned* bst = (volatile __attribute__((address_space(3))) unsigned*)(lds + LDS_MAIN + 128);
  if (threadIdx.x < 2) bst[threadIdx.x] = 0u;
  __syncthreads();
  XcdBarrier xbar; xbar.bar = reinterpret_cast<unsigned*>(ws + O_BAR); xbar.x = 0; xbar.st = bst;
#define PH_BEGIN if (ph >= p.lo && ph < p.hi) {
#define PH_END   if (ph + 1 < p.hi) { if (ph == 0) { cg::this_grid().sync(); xbar = xcd_barrier_post(reinterpret_cast<unsigned*>(ws + O_BAR), bst); } else xcd_barrier(xbar); } } ++ph;

  PH_BEGIN
    if (blockIdx.x == 0 && threadIdx.x < 64) reinterpret_cast<int*>(ws + O_CTR)[threadIdx.x] = 0;
    if (blockIdx.x == 2) for (int i = threadIdx.x; i < XCD_BAR_WORDS; i += NTHR) reinterpret_cast<unsigned*>(ws + O_BAR)[i] = 0u;
    if (blockIdx.x == 1) {
      float2* tg = reinterpret_cast<float2*>(ws + O_ROPEG);
      float2* tm = reinterpret_cast<float2*>(ws + O_ROPEM);
#pragma unroll 1
      for (int i = threadIdx.x; i < 64 * 32 + 64 * 16; i += NTHR) {
        const bool isg = i < 2048;
        const int j = isg ? i : i - 2048;
        const int pos = isg ? (j >> 5) : (j >> 4);
        const int fi = isg ? (j & 31) : (j & 15);
        const float ang = (float)pos * exp2f(-(float)fi * (isg ? (LOG2_THETA / 32.f) : (LOG2_THETA / 16.f)));
        float2 v; v.x = cosf(ang); v.y = sinf(ang);
        if (isg) tg[j] = v; else tm[j] = v;
      }
    }
    phase_mod(p, lds);
    phase_convert(p, 0, lds, 0, sitem);
  PH_END
#if PROBE == 4
  PH_BEGIN
    phase_convert(p, 0, lds, 0, sitem);
  PH_END
#endif
#if PROBE == 9
  for (int e = 0; e < 10; ++e) {
  PH_BEGIN
  PH_END
  }
#endif
  for (int l = 0; l < 2; ++l) {
    PH_BEGIN
      phase_norm_mod(p, l, 0, l == 0, false, l == 1 && gridDim.x == 256);
      if (l == 1) phase_convert(p, 1, lds, 0, sitem);
    PH_END
    PH_BEGIN
      u16* PROJ = reinterpret_cast<u16*>(ws + O_PROJ);
      gemm_phase<true>(reinterpret_cast<const u16*>(ws + O_H), reinterpret_cast<const u16*>(ws + O_WIN), 2048, 36, 43, lds,
                    [=](int r, int c, f32x4 v, int part) { st_bf16x4(PROJ + (size_t)r * DINP + c, v); }, l == 1 ? 3 : 0);
      phase_convert(p, l, lds, 1, sitem);
    PH_END
#if PROBE == 5
    PH_BEGIN
      u16* PROJ = reinterpret_cast<u16*>(ws + O_PROJ);
      gemm_phase<true>(reinterpret_cast<const u16*>(ws + O_H), reinterpret_cast<const u16*>(ws + O_WIN), 2048, 36, 43, lds,
                    [=](int r, int c, f32x4 v, int part) { st_bf16x4(PROJ + (size_t)r * DINP + c, v); }, l == 1 ? 3 : 0);
      phase_convert(p, l, lds, 1, sitem);
    PH_END
#endif
    PH_BEGIN
      phase_post(p, l);
    PH_END
#if PROBE == 3
    PH_BEGIN
      phase_post(p, l);
    PH_END
#endif
    PH_BEGIN
      u16* QRAW = reinterpret_cast<u16*>(ws + O_QRAW);
      u16* KVRAW = reinterpret_cast<u16*>(ws + O_KVRAW);
      gemm_phase<true>(reinterpret_cast<const u16*>(ws + O_CQN), reinterpret_cast<const u16*>(ws + O_WQB), 512, 36, 3, lds,
                    [=](int r, int c, f32x4 v, int part) { st_bf16x4(QRAW + (size_t)r * 768 + c, v); }, l == 1 ? 1 : 0, 0);
      gemm_phase<true>(reinterpret_cast<const u16*>(ws + O_CKVN), reinterpret_cast<const u16*>(ws + O_WKVB), 512, 36, 4, lds,
                    [=](int r, int c, f32x4 v, int part) { st_bf16x4(KVRAW + (size_t)r * 1024 + c, v); }, 0, (gridDim.x >= 252) ? 108 : 0);
      phase_qnorm(p, l);
      {
        int* pctr = reinterpret_cast<int*>(ws + O_CTR) + 6 + l;
        for (;;) {
          if (threadIdx.x == 0) *sitem = atomicAdd(pctr, 1);
          __syncthreads();
          const int it = *sitem;
          __syncthreads();
          if (it >= NPREP) break;
          gdn_prep_item(p, it, lds);
        }
      }
    PH_END
#if PROBE == 2
    PH_BEGIN
      u16* QRAW = reinterpret_cast<u16*>(ws + O_QRAW);
      u16* KVRAW = reinterpret_cast<u16*>(ws + O_KVRAW);
      gemm_phase<true>(reinterpret_cast<const u16*>(ws + O_CQN), reinterpret_cast<const u16*>(ws + O_WQB), 512, 36, 3, lds,
                    [=](int r, int c, f32x4 v, int part) { st_bf16x4(QRAW + (size_t)r * 768 + c, v); }, l == 1 ? 1 : 0, 0);
      gemm_phase<true>(reinterpret_cast<const u16*>(ws + O_CKVN), reinterpret_cast<const u16*>(ws + O_WKVB), 512, 36, 4, lds,
                    [=](int r, int c, f32x4 v, int part) { st_bf16x4(KVRAW + (size_t)r * 1024 + c, v); }, 0, (gridDim.x >= 252) ? 108 : 0);
      {
        int* pctr = reinterpret_cast<int*>(ws + O_CTR) + 8 + l;
        for (;;) {
          if (threadIdx.x == 0) *sitem = atomicAdd(pctr, 1);
          __syncthreads();
          const int it = *sitem;
          __syncthreads();
          if (it >= NPREP) break;
          gdn_prep_item(p, it, lds);
        }
      }
    PH_END
#endif
    PH_BEGIN
      phase_mixers(p, l, lds, sitem, l);
    PH_END
#if PROBE == 1
    PH_BEGIN
      phase_mixers(p, l, lds, sitem, l + 2);
    PH_END
#endif
#if PROBE == 11 || PROBE == 12 || PROBE == 13
    PH_BEGIN
      phase_mixers(p, l, lds, sitem, l + 2, PROBE - 10);
    PH_END
#endif
    PH_BEGIN
      phase_gdn_out(p, l);
    PH_END
#if PROBE == 6
    PH_BEGIN
      phase_gdn_out(p, l);
    PH_END
#endif
    PH_BEGIN
      const u16* PROJ = reinterpret_cast<const u16*>(ws + O_PROJ);
      float* T = reinterpret_cast<float*>(ws + O_PU);
      u16* Y = reinterpret_cast<u16*>(ws + O_H);
      gemm_phase<true>(reinterpret_cast<const u16*>(ws + O_OA), reinterpret_cast<const u16*>(ws + O_WUPA), 512, 36, 8, lds,
                    [=](int r, int c, f32x4 v, int part) {
                      const uint2 gq = *reinterpret_cast<const uint2*>(PROJ + (size_t)r * DINP + C_BG + c);
                      f32x4 o; o[0] = sigmf(bflo(gq.x)) * v[0]; o[1] = sigmf(bfhi(gq.x)) * v[1]; o[2] = sigmf(bflo(gq.y)) * v[2]; o[3] = sigmf(bfhi(gq.y)) * v[3];
                      *reinterpret_cast<f32x4*>(T + (size_t)r * 2048 + c) = o; }, l == 1 ? 1 : 0);
      gemm_phase<true>(reinterpret_cast<const u16*>(ws + O_OBQ), reinterpret_cast<const u16*>(ws + O_WUPB), 1024, 36, 8, lds,
                    [=](int r, int c, f32x4 v, int part) {
                      const uint2 gq = *reinterpret_cast<const uint2*>(PROJ + (size_t)r * DINP + C_BG + 2048 + c);
                      f32x4 o = *reinterpret_cast<const f32x4*>(T + (size_t)r * 2048 + c);
                      o[0] += sigmf(bflo(gq.x)) * v[0]; o[1] += sigmf(bfhi(gq.x)) * v[1]; o[2] += sigmf(bflo(gq.y)) * v[2]; o[3] += sigmf(bfhi(gq.y)) * v[3];
                      *reinterpret_cast<f32x4*>(T + (size_t)r * 2048 + c) = o; }, l == 1 ? 1 : 0);
      gemm_phase<true>(reinterpret_cast<const u16*>(ws + O_OC), reinterpret_cast<const u16*>(ws + O_WUPC), 512, 36, 8, lds,
                    [=](int r, int c, f32x4 v, int part) {
                      const uint2 gq = *reinterpret_cast<const uint2*>(PROJ + (size_t)r * DINP + C_BG + 4096 + c);
                      f32x4 o = *reinterpret_cast<const f32x4*>(T + (size_t)r * 2048 + c);
                      o[0] += sigmf(bflo(gq.x)) * v[0]; o[1] += sigmf(bfhi(gq.x)) * v[1]; o[2] += sigmf(bflo(gq.y)) * v[2]; o[3] += sigmf(bfhi(gq.y)) * v[3];
                      st_bf16x4(Y + (size_t)r * 2048 + c, o); }, l == 1 ? 1 : 0);
    PH_END
    PH_BEGIN
      float* XRES = reinterpret_cast<float*>(ws + O_XRES);
      float* PART = reinterpret_cast<float*>(ws + O_PU);
      const float* xin_lat = p.in[0];
      const float* xin_ctx = p.in[2];
      const float* MOD = reinterpret_cast<const float*>(ws + O_MOD) + (size_t)l * 5 * 12288;
      gemm_phase<false>(reinterpret_cast<const u16*>(ws + O_H), reinterpret_cast<const u16*>(ws + O_WOUT), 2048, 36, 8, lds,
                    [=](int r, int c, f32x4 v, int part) {
                      const int b = r / TPB; const int mr = (r - b * TPB < 2048) ? b : 4;
                      const f32x4 md = *reinterpret_cast<const f32x4*>(MOD + (size_t)mr * 12288 + 2 * 2048 + c);
                      const f32x4 dv = md * v;
                      float* xf = XRES + (size_t)r * 2048 + c;
                      if (part >= 0) {
                        const int cr = b * 256 + (r - b * TPB - 2048);
                        *reinterpret_cast<f32x4*>(PART + ((size_t)part * 1024 + cr) * 2048 + c) = dv;
                      } else {
                        const int tt_ = r - b * TPB;
                        const float* xsrc = (l == 1) ? xf
                                          : ((tt_ < 2048) ? (xin_lat + ((size_t)b * 2048 + tt_) * 2048 + c) : (xin_ctx + ((size_t)b * 256 + (tt_ - 2048)) * 2048 + c));
                        *reinterpret_cast<f32x4*>(xf) = *reinterpret_cast<const f32x4*>(xsrc) + dv;
                      }
                    }, l == 1 ? 1 : 2);
    PH_END
    PH_BEGIN
      phase_norm_mod(p, l, 1, false, l == 1, l == 0 && gridDim.x == 256);
    PH_END
#if PROBE == 7
    PH_BEGIN
      phase_norm_mod(p, l, 1, false, l == 1, l == 0 && gridDim.x == 256);
    PH_END
#endif
    PH_BEGIN
      u16* F = reinterpret_cast<u16*>(ws + O_PROJ);
      gemm_phase<true>(reinterpret_cast<const u16*>(ws + O_H), reinterpret_cast<const u16*>(ws + O_WFF1), 2048, 36, 32, lds,
                    [=](int r, int c, f32x4 v, int part) {
                      f32x4 q; q[0] = fmaxf(v[0], 0.f); q[1] = fmaxf(v[1], 0.f); q[2] = fmaxf(v[2], 0.f); q[3] = fmaxf(v[3], 0.f);
                      st_bf16x4(F + (size_t)r * DFF + c, q * q); }, l == 1 ? 1 : 0);
    PH_END
#if PROBE == 8
    PH_BEGIN
      u16* F = reinterpret_cast<u16*>(ws + O_PROJ);
      gemm_phase<true>(reinterpret_cast<const u16*>(ws + O_H), reinterpret_cast<const u16*>(ws + O_WFF1), 2048, 36, 32, lds,
                    [=](int r, int c, f32x4 v, int part) {
                      f32x4 q; q[0] = fmaxf(v[0], 0.f); q[1] = fmaxf(v[1], 0.f); q[2] = fmaxf(v[2], 0.f); q[3] = fmaxf(v[3], 0.f);
                      st_bf16x4(F + (size_t)r * DFF + c, q * q); }, l == 1 ? 1 : 0);
    PH_END
#endif
    PH_BEGIN
      float* XRES = reinterpret_cast<float*>(ws + O_XRES);
      float* PART = reinterpret_cast<float*>(ws + O_PU);
      const float* MOD = reinterpret_cast<const float*>(ws + O_MOD) + (size_t)l * 5 * 12288;
      gemm_phase<false>(reinterpret_cast<const u16*>(ws + O_PROJ), reinterpret_cast<const u16*>(ws + O_WFF2), DFF, 36, 8, lds,
                    [=](int r, int c, f32x4 v, int part) {
                      const int b = r / TPB; const int mr = (r - b * TPB < 2048) ? b : 4;
                      const f32x4 md = *reinterpret_cast<const f32x4*>(MOD + (size_t)mr * 12288 + 5 * 2048 + c);
                      const f32x4 dv = md * v;
                      float* xf = XRES + (size_t)r * 2048 + c;
                      if (part >= 0) {
                        const int cr = b * 256 + (r - b * TPB - 2048);
                        *reinterpret_cast<f32x4*>(PART + ((size_t)part * 1024 + cr) * 2048 + c) = dv;
                      } else {
                        f32x4* xp = reinterpret_cast<f32x4*>(xf);
                        *xp = *xp + dv;
                      }
                    }, l == 1 ? 1 : 2);
    PH_END
  }
  PH_BEGIN
    phase_final(p);
  PH_END
#undef PH_BEGIN
#undef PH_END
}

extern "C" void kernel_launch(void* const* d_in, const int* in_sizes, int n_in, void* d_out, int out_size, void* d_ws,
                              size_t ws_size, hipStream_t stream) {
  static int grid = 0;
  if (grid == 0) {
    if (n_in != 26 || ws_size < WS_END) { fprintf(stderr, "kernel_launch: bad setup n_in=%d ws=%zu need %zu\n", n_in, ws_size, (size_t)WS_END); grid = -1; return; }
    int dev = 0, cus = 0, per_cu = 0;
    hipGetDevice(&dev);
    hipDeviceGetAttribute(&cus, hipDeviceAttributeMultiprocessorCount, dev);
    hipFuncSetAttribute((const void*)mega, hipFuncAttributeMaxDynamicSharedMemorySize, LDS_BYTES);
    hipOccupancyMaxActiveBlocksPerMultiprocessor(&per_cu, (const void*)mega, NTHR, LDS_BYTES);
    if (per_cu < 1) per_cu = 1;
    grid = cus * per_cu;
    (void)hipGetLastError();
  }
  if (grid < 0) return;
  P p{};
  for (int i = 0; i < 26; ++i) p.in[i] = (const float*)d_in[i];
  p.out = (float*)d_out;
  p.ws = (unsigned char*)d_ws;
#if MULTI
  for (int ph = 0; ph < NPHASE; ++ph) {
    p.lo = ph; p.hi = ph + 1;
    hipLaunchKernelGGL(mega, dim3(grid), dim3(NTHR), LDS_BYTES, stream, p);
  }
#else
  p.lo = 0; p.hi = NPHASE;
  void* args[] = {&p};
  hipError_t e = hipLaunchCooperativeKernel((const void*)mega, dim3(grid), dim3(NTHR), args, LDS_BYTES, stream);
  if (e != hipSuccess) fprintf(stderr, "cooperative launch failed: %s (grid %d)\n", hipGetErrorString(e), grid);
#endif
}
```

```cpp
#include <hip/hip_runtime.h>
#include <hip/hip_cooperative_groups.h>
#include <cstdio>
namespace cg = cooperative_groups;

#ifndef MULTI
#define MULTI 0
#endif
#ifndef PROBE
#define PROBE 0
#endif

typedef unsigned short u16;
#define LAS __attribute__((address_space(3)))
using bf16x8 = __attribute__((ext_vector_type(8))) __bf16;
using u32x4 = __attribute__((ext_vector_type(4))) unsigned;
using nt_f32x4 = __attribute__((ext_vector_type(4))) float;
__device__ __forceinline__ float4 ld_nt(const float* p) { const nt_f32x4 v = __builtin_nontemporal_load(reinterpret_cast<const nt_f32x4*>(p)); return make_float4(v[0], v[1], v[2], v[3]); }
__device__ __forceinline__ void st_nt(float* p, float4 v) { nt_f32x4 o = {v.x, v.y, v.z, v.w}; __builtin_nontemporal_store(o, reinterpret_cast<nt_f32x4*>(p)); }
using f32x16 = __attribute__((ext_vector_type(16))) float;
typedef short v4s __attribute__((ext_vector_type(4)));
typedef short v8s __attribute__((ext_vector_type(8)));

constexpr int NTHR = 512;
constexpr int DM = 2048;
constexpr int TPB = 2304;
constexpr int MROWS = 9216;
constexpr int DIN = 10832, DINP = 11008;
constexpr int DFF = 8192;
constexpr float EPS = 1e-6f;
constexpr float LOG2_THETA = 13.287712379549449f;
constexpr int C_CQ = 0, C_CKV = 512, C_KPE = 1024, C_GQ = 1088, C_GK = 2112, C_GV = 2368, C_QKV = 2624,
              C_BETA = 4160, C_DEC = 4168, C_OG = 4176, C_BG = 4688;

constexpr size_t O_WIN = 0;
constexpr size_t O_WQB = O_WIN + (size_t)DINP * 2048 * 2;
constexpr size_t O_WKVB = O_WQB + (size_t)768 * 512 * 2;
constexpr size_t O_WUPA = O_WKVB + (size_t)1024 * 512 * 2;
constexpr size_t O_WUPB = O_WUPA + (size_t)2048 * 512 * 2;
constexpr size_t O_WUPC = O_WUPB + (size_t)2048 * 1024 * 2;
constexpr size_t O_WOUT = O_WUPC + (size_t)2048 * 512 * 2;
constexpr size_t O_WFF1 = O_WOUT + (size_t)2048 * 2048 * 2;
constexpr size_t O_WFF2 = O_WFF1 + (size_t)8192 * 2048 * 2;
constexpr size_t O_XRES = O_WFF2 + (size_t)8192 * 2048 * 2;
constexpr size_t O_H = O_XRES + (size_t)MROWS * 2048 * 4;
constexpr size_t O_PROJ = O_H + (size_t)MROWS * 2048 * 2;
constexpr size_t O_MOD = O_PROJ + (size_t)MROWS * DINP * 2;
constexpr size_t O_CQN = O_MOD + (size_t)2 * 5 * 12288 * 4;
constexpr size_t O_CKVN = O_CQN + (size_t)MROWS * 512 * 2;
constexpr size_t O_KPE = O_CKVN + (size_t)MROWS * 512 * 2;
constexpr size_t O_GKN = O_KPE + (size_t)MROWS * 64 * 2;
constexpr size_t O_QRAW = O_GKN + (size_t)MROWS * 256 * 2;
constexpr size_t O_KVRAW = O_QRAW + (size_t)MROWS * 768 * 2;
constexpr size_t O_GDQ = O_KVRAW + (size_t)MROWS * 1024 * 2;
constexpr size_t O_GDK = O_GDQ + (size_t)MROWS * 512 * 2;
constexpr size_t O_GDV = O_GDK + (size_t)MROWS * 512 * 2;
constexpr size_t O_BETA = O_GDV + (size_t)MROWS * 512 * 2;
constexpr size_t O_GG = O_BETA + (size_t)MROWS * 8 * 4;
constexpr int NPREP = 1152;
constexpr size_t O_PU = O_GG + (size_t)MROWS * 8 * 4;
constexpr size_t O_PNW = O_PU + (size_t)NPREP * 64 * 128 * 4;
constexpr size_t O_PQT = O_PNW + (size_t)NPREP * 64 * 128 * 2;
constexpr size_t O_PKTT = O_PQT + (size_t)NPREP * 64 * 128 * 2;
constexpr size_t O_PQKD = O_PKTT + (size_t)NPREP * 64 * 128 * 2;
constexpr size_t O_PEGL = O_PQKD + (size_t)NPREP * 64 * 64 * 2;
constexpr size_t O_OF = O_PEGL + 8192;
constexpr size_t O_OB = O_OF + (size_t)MROWS * 512 * 4;
constexpr size_t O_OA = O_OB + (size_t)MROWS * 512 * 4;
constexpr size_t O_OBQ = O_OA + (size_t)MROWS * 512 * 2;
constexpr size_t O_OC = O_OBQ + (size_t)MROWS * 1024 * 2;
constexpr size_t O_CTR = O_OC + (size_t)MROWS * 512 * 2;
constexpr size_t O_ROPEG = O_CTR + 256;
constexpr size_t O_ROPEM = O_ROPEG + 64 * 32 * 8;
constexpr size_t O_GVC = O_ROPEM + 64 * 16 * 8;
constexpr size_t O_GQN = O_GVC + (size_t)MROWS * 256 * 2;
constexpr size_t O_BAR = O_GQN + (size_t)MROWS * 1024 * 2;
constexpr size_t WS_END = O_BAR + 3456 * 4;

constexpr int LDS_MAIN = 139264;
constexpr int LDS_BYTES = LDS_MAIN + 1024;

struct P {
  const float* in[26];
  float* out;
  unsigned char* ws;
  int lo, hi;
};

__device__ __forceinline__ u16 f2bf(float f) {
  unsigned u = __float_as_uint(f);
  u += 0x7fffu + ((u >> 16) & 1u);
  return (u16)(u >> 16);
}
__device__ __forceinline__ float bf2f(u16 h) { return __uint_as_float(((unsigned)h) << 16); }
typedef __bf16 v2bf_t __attribute__((ext_vector_type(2)));
typedef float v2f_t __attribute__((ext_vector_type(2)));
__device__ __forceinline__ unsigned pack2(float a, float b) { v2f_t f = {a, b}; v2bf_t r = __builtin_convertvector(f, v2bf_t); return __builtin_bit_cast(unsigned, r); }
__device__ __forceinline__ float bflo(unsigned u) { return __uint_as_float(u << 16); }
__device__ __forceinline__ float bfhi(unsigned u) { return __uint_as_float(u & 0xffff0000u); }
__device__ __forceinline__ int tid_() { int t = threadIdx.x; asm volatile("" : "+v"(t)); return t; }
__device__ __forceinline__ int tid() { int t = threadIdx.x; asm volatile("" : "+v"(t)); return t; }
__device__ __forceinline__ float wave_sum(float v) {
#pragma unroll
  for (int o = 32; o > 0; o >>= 1) v += __shfl_xor(v, o);
  return v;
}
__device__ __forceinline__ float siluf(float x) { return x / (1.f + __expf(-x)); }
__device__ __forceinline__ float sigmf(float x) { return 1.f / (1.f + __expf(-x)); }
__device__ __forceinline__ f32x16 mfma(bf16x8 a, bf16x8 b, f32x16 c) {
  return __builtin_amdgcn_mfma_f32_32x32x16_bf16(a, b, c, 0, 0, 0);
}
__device__ __forceinline__ bf16x8 ldsfrag(const unsigned char* p) { return *reinterpret_cast<const bf16x8*>(p); }
__device__ __forceinline__ bf16x8 asfrag(uint4 v) {
  u32x4 t = {v.x, v.y, v.z, v.w};
  return __builtin_bit_cast(bf16x8, t);
}

__device__ __forceinline__ void conv_tile(const float* __restrict__ W, int K, int N, int Npad, u16* __restrict__ Wt, int tile, float* sT) {
  const int ntn = Npad >> 8;
  const int kt = tile / ntn, nt = tile - kt * ntn;
  const int k0 = kt * 64, n0 = nt * 256;
  const int t = tid();
  {
    const int n4 = (t & 63) * 4, kk = t >> 6;
    float4 v[8];
#pragma unroll
    for (int j = 0; j < 8; ++j) {
      const int k = kk + 8 * j;
      v[j] = (n0 + n4 < N) ? ld_nt(W + (size_t)(k0 + k) * N + n0 + n4) : make_float4(0.f, 0.f, 0.f, 0.f);
    }
#pragma unroll
    for (int j = 0; j < 8; ++j) {
      const int k = kk + 8 * j;
      float* d = sT + k * 257 + n4;
      d[0] = v[j].x; d[1] = v[j].y; d[2] = v[j].z; d[3] = v[j].w;
    }
  }
  __syncthreads();
  {
    const int k8i = t & 7, nb = t >> 3;
#pragma unroll
    for (int i = 0; i < 4; ++i) {
      const int nn = nb + 64 * i;
      float x[8];
#pragma unroll
      for (int j = 0; j < 8; ++j) x[j] = sT[(k8i * 8 + j) * 257 + nn];
      uint4 o; o.x = pack2(x[0], x[1]); o.y = pack2(x[2], x[3]); o.z = pack2(x[4], x[5]); o.w = pack2(x[6], x[7]);
      *reinterpret_cast<uint4*>(Wt + (size_t)(n0 + nn) * K + k0 + k8i * 8) = o;
    }
  }
  __syncthreads();
}

__device__ __forceinline__ void phase_convert(const P& p, int l, unsigned char* lds, int group, int* sitem) {
  float* sT = reinterpret_cast<float*>(lds);
  unsigned char* ws = p.ws;
  const int n0 = 32 * 43, n1 = 8 * 3, n2 = 8 * 4, n3 = 8 * 8, n4 = 16 * 8, n5 = 8 * 8, n6 = 32 * 8, n7 = 32 * 32, n8 = 128 * 8;
  if (group == 0) {
    for (int it = blockIdx.x; it < n0 + n1 + n2; it += gridDim.x) {
      int r = it;
      if (r < n0) { conv_tile(p.in[7] + (size_t)l * 2048 * DIN, 2048, DIN, DINP, (u16*)(ws + O_WIN), r, sT); continue; }
      r -= n0;
      if (r < n1) { conv_tile(p.in[9] + (size_t)l * 512 * 768, 512, 768, 768, (u16*)(ws + O_WQB), r, sT); continue; }
      r -= n1;
      conv_tile(p.in[11] + (size_t)l * 512 * 1024, 512, 1024, 1024, (u16*)(ws + O_WKVB), r, sT);
    }
    return;
  }
  int* ctr = reinterpret_cast<int*>(ws + O_CTR) + 4 + l;
  const int total = n3 + n4 + n5 + n6 + n7 + n8;
  for (;;) {
    if (threadIdx.x == 0) *sitem = atomicAdd(ctr, 1);
    __syncthreads();
    int r = *sitem;
    __syncthreads();
    if (r >= total) break;
    if (r < n3) { conv_tile(p.in[18] + (size_t)l * 512 * 2048, 512, 2048, 2048, (u16*)(ws + O_WUPA), r, sT); continue; }
    r -= n3;
    if (r < n4) { conv_tile(p.in[19] + (size_t)l * 1024 * 2048, 1024, 2048, 2048, (u16*)(ws + O_WUPB), r, sT); continue; }
    r -= n4;
    if (r < n5) { conv_tile(p.in[20] + (size_t)l * 512 * 2048, 512, 2048, 2048, (u16*)(ws + O_WUPC), r, sT); continue; }
    r -= n5;
    if (r < n6) { conv_tile(p.in[21] + (size_t)l * 2048 * 2048, 2048, 2048, 2048, (u16*)(ws + O_WOUT), r, sT); continue; }
    r -= n6;
    if (r < n7) { conv_tile(p.in[23] + (size_t)l * 2048 * 8192, 2048, 8192, 8192, (u16*)(ws + O_WFF1), r, sT); continue; }
    r -= n7;
    conv_tile(p.in[24] + (size_t)l * 8192 * 2048, 8192, 2048, 2048, (u16*)(ws + O_WFF2), r, sT);
  }
}

__device__ __forceinline__ void phase_mod(const P& p, unsigned char* lds) {
  float* sS = reinterpret_cast<float*>(lds);
  float* sR = reinterpret_cast<float*>(lds + 40960);
  const int t = tid();
  bool inited = false;
  for (int it = (int)gridDim.x - 1 - (int)blockIdx.x; it < 192; it += gridDim.x) {
    if (!inited) {
      for (int i = t; i < 5 * 2048; i += NTHR) {
        int r = i >> 11, k = i & 2047;
        float v = (r < 4) ? p.in[1][r * 2048 + k] : p.in[3][k];
        sS[i] = siluf(v);
      }
      inited = true;
      __syncthreads();
    }
    const int l = it / 96, cgp = it % 96;
    const int nb = cgp * 128;
    const float* W = p.in[4] + (size_t)l * 2048 * 12288;
    const int c4 = t & 31, kq = t >> 5;
    float acc[5][4];
#pragma unroll
    for (int r = 0; r < 5; ++r)
#pragma unroll
      for (int j = 0; j < 4; ++j) acc[r][j] = 0.f;
#pragma unroll 2
    for (int k = kq; k < 2048; k += 16) {
      float4 w = ld_nt(W + (size_t)k * 12288 + nb + c4 * 4);
#pragma unroll
      for (int r = 0; r < 5; ++r) {
        float s = sS[r * 2048 + k];
        acc[r][0] += s * w.x; acc[r][1] += s * w.y; acc[r][2] += s * w.z; acc[r][3] += s * w.w;
      }
    }
#pragma unroll
    for (int r = 0; r < 5; ++r)
#pragma unroll
      for (int j = 0; j < 4; ++j) sR[(kq * 5 + r) * 128 + c4 * 4 + j] = acc[r][j];
    __syncthreads();
    float* MOD = reinterpret_cast<float*>(p.ws + O_MOD);
    for (int o = t; o < 640; o += NTHR) {
      int r = o >> 7, n = o & 127;
      float s = p.in[5][l * 12288 + nb + n];
#pragma unroll
      for (int q = 0; q < 16; ++q) s += sR[(q * 5 + r) * 128 + n];
      MOD[(size_t)(l * 5 + r) * 12288 + nb + n] = s;
    }
    __syncthreads();
  }
}

__device__ __forceinline__ float block_sum(float v, float* sred) {
  v = wave_sum(v);
  const int t = tid();
  if ((t & 63) == 0) sred[t >> 6] = v;
  __syncthreads();
  float s = 0.f;
#pragma unroll
  for (int i = 0; i < 8; ++i) s += sred[i];
  __syncthreads();
  return s;
}

__device__ __forceinline__ void phase_norm_mod(const P& p, int l, int which, bool from_input, bool skipctx, bool addpart) {
  const int t = tid(), lane = t & 63, w = t >> 6;
  float* XRES = reinterpret_cast<float*>(p.ws + O_XRES);
  u16* H = reinterpret_cast<u16*>(p.ws + O_H);
  const float* MOD = reinterpret_cast<const float*>(p.ws + O_MOD);
  const float* g = (which == 0 ? p.in[6] : p.in[22]) + l * 2048;
  for (int R = blockIdx.x * 8 + w; R < MROWS; R += gridDim.x * 8) {
    const int b = R / TPB, tt = R - b * TPB;
    const bool lat = tt < 2048;
    if (skipctx && !lat) continue;
    const float* src;
    if (from_input || (addpart && l == 0 && !lat)) src = lat ? (p.in[0] + ((size_t)b * 2048 + tt) * 2048) : (p.in[2] + ((size_t)b * 256 + (tt - 2048)) * 2048);
    else src = XRES + (size_t)R * 2048;
    float4 x[8];
    float ss = 0.f;
#pragma unroll
    for (int i = 0; i < 8; ++i) {
      x[i] = *reinterpret_cast<const float4*>(src + (lane + 64 * i) * 4);
    }
    const bool fold = addpart && !lat;
    if (fold) {
      const float* PART = reinterpret_cast<const float*>(p.ws + O_PU) + (size_t)(b * 256 + tt - 2048) * 2048;
#pragma unroll 1
      for (int sl = 0; sl < 8; ++sl) {
#pragma unroll
        for (int i = 0; i < 8; ++i) {
          const float4 pv = *reinterpret_cast<const float4*>(PART + (size_t)sl * 1024 * 2048 + (lane + 64 * i) * 4);
          x[i].x += pv.x; x[i].y += pv.y; x[i].z += pv.z; x[i].w += pv.w;
        }
      }
    }
#pragma unroll
    for (int i = 0; i < 8; ++i) ss += x[i].x * x[i].x + x[i].y * x[i].y + x[i].z * x[i].z + x[i].w * x[i].w;
    const int r = lat ? b : 4;
    const float* md = MOD + (size_t)(l * 5 + r) * 12288;
    float4 gva[8], sha[8], sca[8];
#pragma unroll
    for (int i = 0; i < 8; ++i) {
      const int d = (lane + 64 * i) * 4;
      gva[i] = *reinterpret_cast<const float4*>(g + d);
      sha[i] = *reinterpret_cast<const float4*>(md + (which ? 3 : 0) * 2048 + d);
      sca[i] = *reinterpret_cast<const float4*>(md + (which ? 4 : 1) * 2048 + d);
    }
    ss = wave_sum(ss);
    const float rs = rsqrtf(ss * (1.f / 2048.f) + EPS);
#pragma unroll
    for (int i = 0; i < 8; ++i) {
      const int d = (lane + 64 * i) * 4;
      const float4 gv = gva[i], sh = sha[i], sc = sca[i];
      const float y0 = x[i].x * rs * gv.x * (1.f + sc.x) + sh.x;
      const float y1 = x[i].y * rs * gv.y * (1.f + sc.y) + sh.y;
      const float y2 = x[i].z * rs * gv.z * (1.f + sc.z) + sh.z;
      const float y3 = x[i].w * rs * gv.w * (1.f + sc.w) + sh.w;
      uint2 o; o.x = pack2(y0, y1); o.y = pack2(y2, y3);
      *reinterpret_cast<uint2*>(H + (size_t)R * 2048 + d) = o;
      if (fold) *reinterpret_cast<float4*>(XRES + (size_t)R * 2048 + d) = x[i];
    }
  }
}

__device__ __forceinline__ void phase_final(const P& p) {
  const int t = tid(), lane = t & 63, w = t >> 6;
  const float* XRES = reinterpret_cast<const float*>(p.ws + O_XRES);
  for (int q = blockIdx.x * 8 + w; q < 8192; q += gridDim.x * 8) {
    const int b = q >> 11, tt = q & 2047;
    const int R = b * TPB + tt;
    float4 x[8];
    float ss = 0.f;
#pragma unroll
    for (int i = 0; i < 8; ++i) {
      x[i] = *reinterpret_cast<const float4*>(XRES + (size_t)R * 2048 + (lane + 64 * i) * 4);
      ss += x[i].x * x[i].x + x[i].y * x[i].y + x[i].z * x[i].z + x[i].w * x[i].w;
    }
    ss = wave_sum(ss);
    const float rs = rsqrtf(ss * (1.f / 2048.f) + EPS);
#pragma unroll
    for (int i = 0; i < 8; ++i) {
      const int d = (lane + 64 * i) * 4;
      const float4 gv = *reinterpret_cast<const float4*>(p.in[25] + d);
      float4 o; o.x = x[i].x * rs * gv.x; o.y = x[i].y * rs * gv.y; o.z = x[i].z * rs * gv.z; o.w = x[i].w * rs * gv.w;
      st_nt(p.out + (size_t)q * 2048 + d, o);
    }
  }
}

using f32x4 = __attribute__((ext_vector_type(4))) float;
constexpr int G_BM = 256, G_BK = 64, G_HALF = 128, G_HTB = G_HALF * G_BK * 2;
__device__ __forceinline__ int g_lds_byte(int r, int c) { const int st = (r >> 4) * 2 + (c >> 5), rr = r & 15, cc = c & 31, ob = rr * 64 + cc * 2; return st * 1024 + (ob ^ (((ob >> 9) & 1) << 5)); }
__device__ __forceinline__ void g_stage_rc(int b, int& R, int& C) { const int st = b / 1024, sb = b % 1024, swz = sb ^ (((sb >> 9) & 1) << 5); R = (st >> 1) * 16 + swz / 64; C = (st & 1) * 32 + (swz % 64) / 2; }
__device__ __forceinline__ int g_perm32(int rho) { const int n = rho >> 4, i = rho & 15; return 8 * (i >> 2) + 4 * n + (i & 3); }
struct GUnit { int pm, pn, kt0, nkt; };
struct GOrder {
  int nM, nN, nwg, G, c, nt; bool skip, split, ctxk;
  __device__ __forceinline__ void init(int MT, int NT, int G_, int c_, int mode, int nt_) {
    split = (mode == 2) && (G_ == 256) && (NT == 8); ctxk = (mode == 3); skip = (mode == 1) || split || ctxk;
    nM = skip ? 32 : MT; nN = NT; nwg = nM * nN; G = G_; c = c_; nt = nt_; }
  __device__ __forceinline__ bool next(int i, GUnit& u) const {
    if (split && i >= 1) {
      if (i > 1) return false;
      const int ci = c >> 3, sl = c & 7;
      u.pm = 9 * (ci >> 3) + 8; u.pn = ci & 7; u.nkt = nt >> 3; u.kt0 = sl * u.nkt; return true;
    }
    u.kt0 = 0; u.nkt = nt;
    const int L = i * G + c;
    if (ctxk && L >= nwg) {
      const int ci = L - nwg; if (ci >= 48) return false;
      const int j = ci % 12; u.pm = 9 * (ci / 12) + 8; u.pn = (j < 3) ? 2 + j : 5 + j; return true;
    }
    if (L >= nwg) return false;
    int wgid = L; { const int q = nwg / 8, r = nwg % 8, xcd = wgid % 8, off = wgid / 8; wgid = (xcd < r ? xcd * (q + 1) : r * (q + 1) + (xcd - r) * q) + off; }
    const int nig = 8 * nN, gid = wgid / nig, fm = gid * 8, gsz = (nM - fm) < 8 ? (nM - fm) : 8;
    u.pm = fm + ((wgid % nig) % gsz); u.pn = (wgid % nig) / gsz;
    if (skip) u.pm += (u.pm >> 3);
    return true;
  }
};
template <bool PERM, class F>
__device__ __forceinline__ void gemm_phase(const u16* A, const u16* Bt, int K, int MT, int NT, unsigned char* lds_generic, F epi, int mode = 0, int cofs = 0) {
  LAS unsigned char* lds = (LAS unsigned char*)lds_generic;
  const int tid = tid_(), wid = __builtin_amdgcn_readfirstlane(tid >> 6), lane = tid & 63, wr = wid >> 2, wc = wid & 3, fr = lane & 15, fq = lane >> 4;
  const int nt = K / G_BK;
  unsigned voffA[2], voffB[2];
#pragma unroll
  for (int i = 0; i < 2; ++i) { int R, C; g_stage_rc(tid * 16 + i * 8192, R, C); const int Rb = PERM ? ((R & ~31) + g_perm32(R & 31)) : R;
    voffA[i] = (unsigned)(R * K + C) * 2u; voffB[i] = (unsigned)(Rb * K + C) * 2u; }
  const size_t kstep = (size_t)(G_BK * 2);
  const size_t hstep = (size_t)G_HALF * K * 2;
  const size_t tstep = 2 * hstep;
  const unsigned ldsw = (unsigned)wid * 1024u;
  const int aoff = g_lds_byte(wr * 64 + fr, fq * 8), boff = g_lds_byte(wc * 32 + fr, fq * 8);
#define PG8_SA(b, h) (((b) * 2 + (h)) * G_HTB)
#define PG8_SB(b, h) ((4 + (b) * 2 + (h)) * G_HTB)
#define PG8_STAGE(bufoff, gbase, voff) do { _Pragma("unroll") for (int _i = 0; _i < 2; ++_i) \
    __builtin_amdgcn_global_load_lds((const unsigned*)((const char*)(gbase) + (voff)[_i]), (LAS unsigned*)(lds + (bufoff) + ldsw + _i * 8192), 16, 0, 0); } while (0)
#define PG8_LDA(dst, b, h) do { _Pragma("unroll") for (int m = 0; m < 4; ++m) _Pragma("unroll") for (int k = 0; k < 2; ++k) dst[m][k] = *(const LAS bf16x8*)(lds + PG8_SA(b, h) + aoff + m * 2048 + k * 1024); } while (0)
#define PG8_LDB(dst, b, h) do { _Pragma("unroll") for (int n = 0; n < 2; ++n) _Pragma("unroll") for (int k = 0; k < 2; ++k) dst[n][k] = *(const LAS bf16x8*)(lds + PG8_SB(b, h) + boff + n * 2048 + k * 1024); } while (0)
#define PG8_MMA(ai, bj, At, Bt_) do { __builtin_amdgcn_s_setprio(1); _Pragma("unroll") for (int m = 0; m < 4; ++m) _Pragma("unroll") for (int n = 0; n < 2; ++n) _Pragma("unroll") for (int k = 0; k < 2; ++k) \
    acc[ai][bj][m][n] = __builtin_amdgcn_mfma_f32_16x16x32_bf16(Bt_[n][k], At[m][k], acc[ai][bj][m][n], 0, 0, 0); __builtin_amdgcn_s_setprio(0); } while (0)
#define PG8_WAIT_V(n) asm volatile("s_waitcnt vmcnt(" #n ")" ::: "memory")
#define PG8_WAIT_L(n) asm volatile("s_waitcnt lgkmcnt(" #n ")" ::: "memory")
#define PG8_BAR __builtin_amdgcn_s_barrier()
#define PG8_SCHED __builtin_amdgcn_sched_barrier(0)
  if ((int)blockIdx.x < cofs) return;
  GOrder S; S.init(MT, NT, (int)gridDim.x, (int)blockIdx.x - cofs, mode, nt);
  GUnit cur, nxt; int ui = 0;
  if (!S.next(0, cur)) return;
  f32x4 acc[2][2][4][2];
#pragma unroll
  for (int a = 0; a < 2; ++a)
#pragma unroll
    for (int b = 0; b < 2; ++b)
#pragma unroll
      for (int m = 0; m < 4; ++m)
#pragma unroll
        for (int n = 0; n < 2; ++n) acc[a][b][m][n] = (f32x4){0.f, 0.f, 0.f, 0.f};
  bf16x8 At[4][2], B0[2][2], B1[2][2];
  const char* cA = (const char*)A + (size_t)cur.pm * tstep + (size_t)cur.kt0 * kstep; const char* cB = (const char*)Bt + (size_t)cur.pn * tstep + (size_t)cur.kt0 * kstep;
  PG8_STAGE(PG8_SB(0, 0), cB, voffB); PG8_STAGE(PG8_SA(0, 0), cA, voffA); PG8_STAGE(PG8_SB(0, 1), cB + hstep, voffB); PG8_STAGE(PG8_SA(0, 1), cA + hstep, voffA);
  if (wr == 1) PG8_BAR;
  PG8_WAIT_V(4); PG8_BAR;
  PG8_STAGE(PG8_SB(1, 0), cB + kstep, voffB); PG8_STAGE(PG8_SA(1, 0), cA + kstep, voffA); PG8_STAGE(PG8_SB(1, 1), cB + hstep + kstep, voffB);
  PG8_WAIT_V(6); PG8_BAR;
  for (;;) {
    const bool has_next = S.next(ui + 1, nxt);
    const char* nA = has_next ? (const char*)A + (size_t)nxt.pm * tstep + (size_t)nxt.kt0 * kstep : cA; const char* nB = has_next ? (const char*)Bt + (size_t)nxt.pn * tstep + (size_t)nxt.kt0 * kstep : cB;
    const int cnkt = cur.nkt;
    for (int t = 0; t < cnkt; t += 2) {
      const bool last = (t == cnkt - 2);
      const char* a1 = cA + (size_t)(t + 1) * kstep;
      const char* a2 = last ? nA : cA + (size_t)(t + 2) * kstep; const char* b2 = last ? nB : cB + (size_t)(t + 2) * kstep;
      const char* a3 = a2 + kstep; const char* b3 = b2 + kstep;
      PG8_LDB(B0, 0, 0); PG8_SCHED; PG8_LDA(At, 0, 0); PG8_STAGE(PG8_SA(1, 1), a1 + hstep, voffA);
      PG8_WAIT_L(8); PG8_BAR; PG8_WAIT_L(0); PG8_MMA(0, 0, At, B0); PG8_BAR; PG8_SCHED;
      PG8_LDB(B1, 0, 1); PG8_STAGE(PG8_SB(0, 0), b2, voffB);
      PG8_BAR; PG8_WAIT_L(0); PG8_MMA(0, 1, At, B1); PG8_BAR;
      PG8_LDA(At, 0, 1); PG8_STAGE(PG8_SA(0, 0), a2, voffA);
      PG8_BAR; PG8_WAIT_L(0); PG8_MMA(1, 0, At, B0); PG8_BAR; PG8_SCHED;
      PG8_STAGE(PG8_SB(0, 1), b2 + hstep, voffB);
      PG8_WAIT_V(6); PG8_BAR; PG8_MMA(1, 1, At, B1); PG8_BAR;
      PG8_LDB(B0, 1, 0); PG8_SCHED; PG8_LDA(At, 1, 0); PG8_STAGE(PG8_SA(0, 1), a2 + hstep, voffA);
      PG8_WAIT_L(8); PG8_BAR; PG8_WAIT_L(0); PG8_MMA(0, 0, At, B0); PG8_BAR; PG8_SCHED;
      PG8_LDB(B1, 1, 1); PG8_STAGE(PG8_SB(1, 0), b3, voffB);
      PG8_BAR; PG8_WAIT_L(0); PG8_MMA(0, 1, At, B1); PG8_BAR;
      PG8_LDA(At, 1, 1); PG8_STAGE(PG8_SA(1, 0), a3, voffA);
      PG8_BAR; PG8_WAIT_L(0); PG8_MMA(1, 0, At, B0); PG8_BAR; PG8_SCHED;
      PG8_STAGE(PG8_SB(1, 1), b3 + hstep, voffB);
      PG8_WAIT_V(6); PG8_BAR; PG8_MMA(1, 1, At, B1); PG8_BAR;
    }
    {
      const int part = (cur.nkt != nt) ? (cur.kt0 / cur.nkt) : -1;
      const int row0 = cur.pm * G_BM + wr * 64 + fr;
      const int col0 = cur.pn * G_BM + wc * 32 + (PERM ? 8 * fq : 4 * fq);
#pragma unroll
      for (int ai = 0; ai < 2; ++ai)
#pragma unroll
        for (int m = 0; m < 4; ++m) {
          const int row = row0 + ai * G_HALF + m * 16;
#pragma unroll
          for (int bj = 0; bj < 2; ++bj)
#pragma unroll
            for (int n = 0; n < 2; ++n) epi(row, col0 + bj * G_HALF + (PERM ? 4 * n : 16 * n), acc[ai][bj][m][n], part);
        }
    }
    if (!has_next) break;
#pragma unroll
    for (int a = 0; a < 2; ++a)
#pragma unroll
      for (int b = 0; b < 2; ++b)
#pragma unroll
        for (int m = 0; m < 4; ++m)
#pragma unroll
          for (int n = 0; n < 2; ++n) acc[a][b][m][n] = (f32x4){0.f, 0.f, 0.f, 0.f};
    cur = nxt; cA = nA; cB = nB; ++ui;
  }
  PG8_WAIT_V(0);
  if (wr == 0) PG8_BAR;
  PG8_BAR;
#undef PG8_SA
#undef PG8_SB
#undef PG8_STAGE
#undef PG8_LDA
#undef PG8_LDB
#undef PG8_MMA
#undef PG8_WAIT_V
#undef PG8_WAIT_L
#undef PG8_BAR
#undef PG8_SCHED
}

__device__ __forceinline__ void st_bf16x4(u16* dst, f32x4 v) {
  uint2 o; o.x = pack2(v[0], v[1]); o.y = pack2(v[2], v[3]);
  *reinterpret_cast<uint2*>(dst) = o;
}

__device__ __forceinline__ void unpack8(uint4 v, float (&x)[8]) {
  x[0] = bflo(v.x); x[1] = bfhi(v.x); x[2] = bflo(v.y); x[3] = bfhi(v.y); x[4] = bflo(v.z); x[5] = bfhi(v.z); x[6] = bflo(v.w); x[7] = bfhi(v.w);
}
__device__ __forceinline__ void phase_post(const P& p, int l) {
  unsigned char* ws = p.ws;
  const u16* __restrict__ PROJ = reinterpret_cast<const u16*>(ws + O_PROJ);
  const int t = tid(), lane = t & 63, w = __builtin_amdgcn_readfirstlane(t >> 6);
  const int gw = blockIdx.x * 8 + w, nw = gridDim.x * 8;
  for (int item = gw; item < 1152 * 6; item += nw) {
    const int role = item / 1152;
    const int rg = item - role * 1152;
    const int R0 = rg * 8;
    const int b = R0 / TPB, tt0 = R0 - b * TPB;
    const bool lat = tt0 < 2048;
    if (role < 4) {
      const int h = role;
      const float* wc = p.in[14] + (size_t)l * 5 * 1536;
      const int segpos0 = lat ? tt0 : tt0 - 2048;
      const int seglen = lat ? 2048 : 256;
      unsigned xin[3][12];
#pragma unroll
      for (int part = 0; part < 3; ++part)
#pragma unroll
        for (int rr = 0; rr < 12; ++rr) {
          const int sp = segpos0 + rr - 2;
          xin[part][rr] = (sp >= 0 && sp < seglen) ? *reinterpret_cast<const unsigned*>(PROJ + (size_t)(R0 + rr - 2) * DINP + C_QKV + part * 512 + h * 128 + 2 * lane) : 0u;
        }
      float2 wv[3][5];
#pragma unroll
      for (int part = 0; part < 3; ++part)
#pragma unroll
        for (int j = 0; j < 5; ++j) wv[part][j] = *reinterpret_cast<const float2*>(wc + j * 1536 + part * 512 + h * 128 + 2 * lane);
      u16* GQ = reinterpret_cast<u16*>(ws + O_GDQ) + h * 128 + 2 * lane;
      u16* GK = reinterpret_cast<u16*>(ws + O_GDK) + h * 128 + 2 * lane;
      u16* GV = reinterpret_cast<u16*>(ws + O_GDV) + h * 128 + 2 * lane;
#pragma unroll
      for (int rr = 0; rr < 8; ++rr) {
        float v0[3], v1[3];
#pragma unroll
        for (int part = 0; part < 3; ++part) {
          float s0 = 0.f, s1 = 0.f;
#pragma unroll
          for (int j = 0; j < 5; ++j) { s0 += wv[part][j].x * bflo(xin[part][rr + j]); s1 += wv[part][j].y * bfhi(xin[part][rr + j]); }
          v0[part] = siluf(s0); v1[part] = siluf(s1);
        }
        const float sq = wave_sum(v0[0] * v0[0] + v1[0] * v1[0]);
        const float sk = wave_sum(v0[1] * v0[1] + v1[1] * v1[1]);
        const float rq = rsqrtf(sq + EPS) * 0.08838834764831845f;
        const float rk = rsqrtf(sk + EPS);
        const size_t ro = (size_t)(R0 + rr) * 512;
        *reinterpret_cast<unsigned*>(GQ + ro) = pack2(v0[0] * rq, v1[0] * rq);
        *reinterpret_cast<unsigned*>(GK + ro) = pack2(v0[1] * rk, v1[1] * rk);
        *reinterpret_cast<unsigned*>(GV + ro) = pack2(v0[2], v1[2]);
      }
    } else if (role == 4) {
      uint4 vq[8], vk[8];
#pragma unroll
      for (int rr = 0; rr < 8; ++rr) {
        vq[rr] = *reinterpret_cast<const uint4*>(PROJ + (size_t)(R0 + rr) * DINP + C_CQ + lane * 8);
        vk[rr] = *reinterpret_cast<const uint4*>(PROJ + (size_t)(R0 + rr) * DINP + C_CKV + lane * 8);
      }
      float gq[8], gk[8];
#pragma unroll
      for (int j = 0; j < 8; ++j) { gq[j] = p.in[8][l * 512 + lane * 8 + j]; gk[j] = p.in[10][l * 512 + lane * 8 + j]; }
#pragma unroll
      for (int rr = 0; rr < 8; ++rr) {
#pragma unroll
        for (int which = 0; which < 2; ++which) {
          float x[8];
          unpack8(which ? vk[rr] : vq[rr], x);
          float ss = 0.f;
#pragma unroll
          for (int j = 0; j < 8; ++j) ss += x[j] * x[j];
          ss = wave_sum(ss);
          const float rs = rsqrtf(ss * (1.f / 512.f) + EPS);
          uint4 o;
          if (which) { o.x = pack2(x[0] * rs * gk[0], x[1] * rs * gk[1]); o.y = pack2(x[2] * rs * gk[2], x[3] * rs * gk[3]); o.z = pack2(x[4] * rs * gk[4], x[5] * rs * gk[5]); o.w = pack2(x[6] * rs * gk[6], x[7] * rs * gk[7]); }
          else { o.x = pack2(x[0] * rs * gq[0], x[1] * rs * gq[1]); o.y = pack2(x[2] * rs * gq[2], x[3] * rs * gq[3]); o.z = pack2(x[4] * rs * gq[4], x[5] * rs * gq[5]); o.w = pack2(x[6] * rs * gq[6], x[7] * rs * gq[7]); }
          u16* dst = reinterpret_cast<u16*>(ws + (which ? O_CKVN : O_CQN)) + (size_t)(R0 + rr) * 512;
          *reinterpret_cast<uint4*>(dst + lane * 8) = o;
        }
      }
    } else {
      const int hd = lane >> 5, i = lane & 31;
      const float* g = p.in[13] + l * 128;
      const float g0 = g[i], g1 = g[i + 32], g2 = g[64 + i], g3 = g[96 + i];
      u16 xr[8][4];
      u16 kr[8][2];
      u16 br[8];
      uint2 gvr[8];
#pragma unroll
      for (int rr = 0; rr < 8; ++rr) {
        const u16* pr = PROJ + (size_t)(R0 + rr) * DINP;
        const u16* src = pr + C_GK + hd * 128;
        xr[rr][0] = src[i]; xr[rr][1] = src[i + 32]; xr[rr][2] = src[64 + i]; xr[rr][3] = src[96 + i];
        const int ki = lane & 15, kb = ((lane >> 4) & 1) * 32;
        kr[rr][0] = pr[C_KPE + kb + ki]; kr[rr][1] = pr[C_KPE + kb + 16 + ki];
        br[rr] = pr[C_BETA + (lane & 15)];
        gvr[rr] = *reinterpret_cast<const uint2*>(pr + C_GV + lane * 4);
      }
#pragma unroll
      for (int rr = 0; rr < 8; ++rr) {
        const int R = R0 + rr, tt = tt0 + rr;
        float x0 = bf2f(xr[rr][0]), x1 = bf2f(xr[rr][1]), x2 = bf2f(xr[rr][2]), x3 = bf2f(xr[rr][3]);
        float ss = x0 * x0 + x1 * x1 + x2 * x2 + x3 * x3;
#pragma unroll
        for (int o = 16; o > 0; o >>= 1) ss += __shfl_xor(ss, o);
        const float rs = rsqrtf(ss * (1.f / 128.f) + EPS);
        x0 *= rs * g0; x1 *= rs * g1; x2 *= rs * g2; x3 *= rs * g3;
        if (lat) {
          const float2 r1 = reinterpret_cast<const float2*>(ws + O_ROPEG)[(tt >> 6) * 32 + i];
          const float2 r2 = reinterpret_cast<const float2*>(ws + O_ROPEG)[(tt & 63) * 32 + i];
          const float y0 = x0 * r1.x - x1 * r1.y, y1 = x1 * r1.x + x0 * r1.y;
          const float y2 = x2 * r2.x - x3 * r2.y, y3 = x3 * r2.x + x2 * r2.y;
          x0 = y0; x1 = y1; x2 = y2; x3 = y3;
        }
        *reinterpret_cast<uint2*>(reinterpret_cast<u16*>(ws + O_GVC) + (size_t)R * 256 + lane * 4) = gvr[rr];
        u16* dst = reinterpret_cast<u16*>(ws + O_GKN) + (size_t)R * 256 + hd * 128;
        dst[i] = f2bf(x0); dst[i + 32] = f2bf(x1); dst[64 + i] = f2bf(x2); dst[96 + i] = f2bf(x3);
        if (lane < 32) {
          const int ki = lane & 15, kb = (lane >> 4) * 32;
          const float a1 = bf2f(kr[rr][0]), a2 = bf2f(kr[rr][1]);
          float o1 = a1, o2 = a2;
          if (lat) {
            const float2 csn = reinterpret_cast<const float2*>(ws + O_ROPEM)[((lane >> 4) ? (tt & 63) : (tt >> 6)) * 16 + ki];
            o1 = a1 * csn.x - a2 * csn.y; o2 = a2 * csn.x + a1 * csn.y;
          }
          u16* KPE = reinterpret_cast<u16*>(ws + O_KPE) + (size_t)R * 64;
          KPE[kb + ki] = f2bf(o1); KPE[kb + 16 + ki] = f2bf(o2);
        } else if (lane < 48) {
          const int j = lane - 32;
          const float raw = bf2f(br[rr]);
          if (j < 8) {
            reinterpret_cast<float*>(ws + O_BETA)[(size_t)R * 8 + j] = sigmf(raw);
          } else {
            const int jj = j - 8;
            const float xx = raw + p.in[16][l * 8 + jj];
            const float sp = fmaxf(xx, 0.f) + log1pf(__expf(-fabsf(xx)));
            reinterpret_cast<float*>(ws + O_GG)[(size_t)R * 8 + jj] = -__expf(p.in[15][l * 8 + jj]) * sp;
          }
        }
      }
    }
  }
}

__device__ __forceinline__ void phase_qnorm(const P& p, int l) {
  unsigned char* ws = p.ws;
  const u16* __restrict__ PROJ = reinterpret_cast<const u16*>(ws + O_PROJ);
  const int t = tid(), lane = t & 63, w = __builtin_amdgcn_readfirstlane(t >> 6);
  for (int rg = blockIdx.x * 8 + w; rg < 1152; rg += gridDim.x * 8) {
    const int R0 = rg * 8;
    const int b = R0 / TPB, tt0 = R0 - b * TPB;
    const bool lat = tt0 < 2048;
    {
      int hq = lane >> 3, i4 = (lane & 7) * 4;
      asm volatile("" : "+v"(hq), "+v"(i4));
      const float* g = p.in[12] + l * 128;
      float gs[4][4];
#pragma unroll
      for (int k = 0; k < 4; ++k) { const float4 gv = *reinterpret_cast<const float4*>(g + 32 * k + i4); gs[k][0] = gv.x; gs[k][1] = gv.y; gs[k][2] = gv.z; gs[k][3] = gv.w; }
      const float4* tg4 = reinterpret_cast<const float4*>(ws + O_ROPEG);
      u16* GQN = reinterpret_cast<u16*>(ws + O_GQN);
#pragma unroll 1
      for (int hb = 0; hb < 8; hb += 4) {
      uint2 xr[4][4];
#pragma unroll
      for (int rr = 0; rr < 4; ++rr)
#pragma unroll
        for (int k = 0; k < 4; ++k) xr[rr][k] = *reinterpret_cast<const uint2*>(PROJ + (size_t)(R0 + hb + rr) * DINP + C_GQ + hq * 128 + 32 * k + i4);
#pragma unroll
      for (int rr = 0; rr < 4; ++rr) {
        const int R = R0 + hb + rr, tt = tt0 + hb + rr;
        float a[4][4];
        float ss = 0.f;
#pragma unroll
        for (int k = 0; k < 4; ++k) {
          a[k][0] = bflo(xr[rr][k].x); a[k][1] = bfhi(xr[rr][k].x); a[k][2] = bflo(xr[rr][k].y); a[k][3] = bfhi(xr[rr][k].y);
#pragma unroll
          for (int j = 0; j < 4; ++j) ss += a[k][j] * a[k][j];
        }
        ss += __shfl_xor(ss, 1); ss += __shfl_xor(ss, 2); ss += __shfl_xor(ss, 4);
        const float rs = rsqrtf(ss * (1.f / 128.f) + EPS);
#pragma unroll
        for (int k = 0; k < 4; ++k)
#pragma unroll
          for (int j = 0; j < 4; ++j) a[k][j] *= rs * gs[k][j];
        if (lat) {
#pragma unroll
          for (int pr = 0; pr < 2; ++pr) {
            const int pos = pr ? (tt & 63) : (tt >> 6);
            const float4 t0 = tg4[(pos * 32 + i4) >> 1], t1 = tg4[((pos * 32 + i4) >> 1) + 1];
            const float cs[4] = {t0.x, t0.z, t1.x, t1.z}, sn[4] = {t0.y, t0.w, t1.y, t1.w};
#pragma unroll
            for (int j = 0; j < 4; ++j) {
              const float x1 = a[2 * pr][j], x2 = a[2 * pr + 1][j];
              a[2 * pr][j] = x1 * cs[j] - x2 * sn[j];
              a[2 * pr + 1][j] = x2 * cs[j] + x1 * sn[j];
            }
          }
        }
#pragma unroll
        for (int k = 0; k < 4; ++k) {
          uint2 o; o.x = pack2(a[k][0], a[k][1]); o.y = pack2(a[k][2], a[k][3]);
          *reinterpret_cast<uint2*>(GQN + (size_t)R * 1024 + hq * 128 + 32 * k + i4) = o;
        }
      }
      }
    }
  }
}

__device__ __forceinline__ void gdn_prep_item(const P& p, int pid, unsigned char* lds) {
  unsigned char* ws = p.ws;
  const int n = pid % 36; int r = pid / 36;
  const int h = r & 3; r >>= 2;
  const int dir = r & 1; const int b = r >> 1;
  const int Rb = b * TPB + n * 64;
  const int t = tid(), lane = t & 63, w = t >> 6, hf = lane >> 5, l31 = lane & 31;
  unsigned char* sK = lds;
  unsigned char* sQ = lds + 16384;
  unsigned char* sV = lds + 32768;
  float* sA = reinterpret_cast<float*>(lds + 49152);
  float* sgc = reinterpret_cast<float*>(lds + 65536);
  float* sbt = sgc + 64;
  float* sg = sbt + 64;
  const u16* GQ = reinterpret_cast<const u16*>(ws + O_GDQ);
  const u16* GK = reinterpret_cast<const u16*>(ws + O_GDK);
  const u16* GV = reinterpret_cast<const u16*>(ws + O_GDV);
#pragma unroll
  for (int i = 0; i < 2; ++i) {
    const int id = t + 512 * i;
    const int row = id >> 4, c = id & 15;
    const int R = Rb + (dir ? 63 - row : row);
    const size_t go = (size_t)R * 512 + h * 128 + c * 8;
    uint4 kq = *reinterpret_cast<const uint4*>(GK + go);
    uint4 qq = *reinterpret_cast<const uint4*>(GQ + go);
    uint4 vq = *reinterpret_cast<const uint4*>(GV + go);
    const int so = row * 256 + ((c ^ (row & 7)) << 4);
    *reinterpret_cast<uint4*>(sK + so) = kq;
    *reinterpret_cast<uint4*>(sQ + so) = qq;
    *reinterpret_cast<uint4*>(sV + row * 256 + c * 16) = vq;
  }
  if (t < 64) {
    const int R = Rb + (dir ? 63 - t : t);
    sg[t] = reinterpret_cast<const float*>(ws + O_GG)[(size_t)R * 8 + dir * 4 + h];
    sbt[t] = reinterpret_cast<const float*>(ws + O_BETA)[(size_t)R * 8 + dir * 4 + h];
  }
  __syncthreads();
  if (t < 64) {
    float s = sg[t];
#pragma unroll
    for (int o = 1; o < 64; o <<= 1) { const float v = __shfl_up(s, o); if (t >= o) s += v; }
    sgc[t] = s;
  }
  __syncthreads();
  {
    const int wt = w & 3, it = wt >> 1, jt = wt & 1;
    const unsigned char* sX = (w < 4) ? sK : sQ;
    f32x16 acc;
#pragma unroll
    for (int i = 0; i < 16; ++i) acc[i] = 0.f;
#pragma unroll
    for (int ks = 0; ks < 8; ++ks) {
      const int c = ks * 2 + hf;
      const int ra = it * 32 + l31, rb = jt * 32 + l31;
      bf16x8 a = ldsfrag(sX + ra * 256 + ((c ^ (ra & 7)) << 4));
      bf16x8 bb = ldsfrag(sK + rb * 256 + ((c ^ (rb & 7)) << 4));
      acc = mfma(a, bb, acc);
    }
    const int cj = jt * 32 + l31;
    const float gcc = sgc[cj];
    u16* QKD = reinterpret_cast<u16*>(ws + O_PQKD) + (size_t)pid * 4096;
#pragma unroll
    for (int x = 0; x < 16; ++x) {
      const int ri = it * 32 + 8 * (x >> 2) + 4 * hf + (x & 3);
      if (w < 4) {
        const float dec = __expf(fminf(gcc - sgc[ri], 0.f));
        sA[ri * 64 + cj] = (cj > ri) ? sbt[cj] * acc[x] * dec : 0.f;
      } else {
        const float dec = __expf(fminf(sgc[ri] - gcc, 0.f));
        QKD[ri * 64 + cj] = f2bf((ri >= cj) ? acc[x] * dec : 0.f);
      }
    }
  }
  __syncthreads();
  if (t < 256) {
    const int c = t;
    const bool isu = c < 128;
    const int d = c & 127;
    float* sX = reinterpret_cast<float*>(lds + 69632);
    float* U = reinterpret_cast<float*>(ws + O_PU) + (size_t)pid * 8192;
    u16* NW = reinterpret_cast<u16*>(ws + O_PNW) + (size_t)pid * 8192;
#pragma unroll 1
    for (int B = 0; B < 4; ++B) {
      const int i0 = B * 16;
      float s[16];
#pragma unroll
      for (int r = 0; r < 16; ++r) {
        const int i = i0 + r;
        if (isu) s[r] = bf2f(*reinterpret_cast<const u16*>(sV + i * 256 + d * 2)) * sbt[i];
        else s[r] = bf2f(*reinterpret_cast<const u16*>(sK + i * 256 + (((d >> 3) ^ (i & 7)) << 4) + (d & 7) * 2)) * sbt[i] * __expf(sgc[i]);
      }
#pragma unroll 1
      for (int j = 0; j < i0; j += 4) {
        float xj[4]; float4 av[4][4];
#pragma unroll
        for (int u = 0; u < 4; ++u) {
          xj[u] = sX[(j + u) * 256 + c];
          const float4* ap = reinterpret_cast<const float4*>(sA + (j + u) * 64 + i0);
          av[u][0] = ap[0]; av[u][1] = ap[1]; av[u][2] = ap[2]; av[u][3] = ap[3];
        }
        __builtin_amdgcn_sched_barrier(0);
#pragma unroll
        for (int u = 0; u < 4; ++u) {
          const float nx = -xj[u];
          s[0] = __builtin_fmaf(av[u][0].x, nx, s[0]); s[1] = __builtin_fmaf(av[u][0].y, nx, s[1]); s[2] = __builtin_fmaf(av[u][0].z, nx, s[2]); s[3] = __builtin_fmaf(av[u][0].w, nx, s[3]);
          s[4] = __builtin_fmaf(av[u][1].x, nx, s[4]); s[5] = __builtin_fmaf(av[u][1].y, nx, s[5]); s[6] = __builtin_fmaf(av[u][1].z, nx, s[6]); s[7] = __builtin_fmaf(av[u][1].w, nx, s[7]);
          s[8] = __builtin_fmaf(av[u][2].x, nx, s[8]); s[9] = __builtin_fmaf(av[u][2].y, nx, s[9]); s[10] = __builtin_fmaf(av[u][2].z, nx, s[10]); s[11] = __builtin_fmaf(av[u][2].w, nx, s[11]);
          s[12] = __builtin_fmaf(av[u][3].x, nx, s[12]); s[13] = __builtin_fmaf(av[u][3].y, nx, s[13]); s[14] = __builtin_fmaf(av[u][3].z, nx, s[14]); s[15] = __builtin_fmaf(av[u][3].w, nx, s[15]);
        }
        __builtin_amdgcn_sched_barrier(0);
      }
#pragma unroll
      for (int rp = 0; rp < 15; ++rp) {
        const float4* ap = reinterpret_cast<const float4*>(sA + (i0 + rp) * 64 + i0);
        const float4 a0 = ap[0], a1 = ap[1], a2 = ap[2], a3 = ap[3];
        const float av[16] = {a0.x, a0.y, a0.z, a0.w, a1.x, a1.y, a1.z, a1.w, a2.x, a2.y, a2.z, a2.w, a3.x, a3.y, a3.z, a3.w};
#pragma unroll
        for (int r = rp + 1; r < 16; ++r) s[r] -= av[r] * s[rp];
      }
#pragma unroll
      for (int r = 0; r < 16; ++r) {
        sX[(i0 + r) * 256 + c] = s[r];
        if (isu) U[(i0 + r) * 128 + d] = s[r];
        else NW[(i0 + r) * 128 + d] = f2bf(-s[r]);
      }
    }
  } else {
    const int tq = t - 256;
    u16* QT = reinterpret_cast<u16*>(ws + O_PQT) + (size_t)pid * 8192;
    u16* KTT = reinterpret_cast<u16*>(ws + O_PKTT) + (size_t)pid * 8192;
    const float gl = sgc[63];
    for (int rr = 0; rr < 32; ++rr) {
      const int idx = tq + 256 * rr;
      {
        const int i = idx >> 7, d = idx & 127;
        float q = bf2f(*reinterpret_cast<const u16*>(sQ + i * 256 + (((d >> 3) ^ (i & 7)) << 4) + (d & 7) * 2));
        QT[i * 128 + d] = f2bf(q * __expf(sgc[i]));
      }
      {
        const int i = idx & 63, d = idx >> 6;
        float k = bf2f(*reinterpret_cast<const u16*>(sK + i * 256 + (((d >> 3) ^ (i & 7)) << 4) + (d & 7) * 2));
        KTT[d * 64 + i] = f2bf(k * __expf(gl - sgc[i]));
      }
    }
    if (tq == 0) reinterpret_cast<float*>(ws + O_PEGL)[pid] = __expf(gl);
  }
  __syncthreads();
}

__device__ __forceinline__ int scan_chunk(int dir, int step) { return dir ? 35 - step : (step < 4 ? 32 + step : step - 4); }
__device__ __forceinline__ void gdn_scan_item(const P& p, int item, unsigned char* lds) {
  unsigned char* ws = p.ws;
  const int h = item & 3, dir = (item >> 2) & 1, b = item >> 3;
  const int t = tid(), lane = t & 63, w = t >> 6, hf = lane >> 5, l31 = lane & 31;
  unsigned char* sST = lds;
  unsigned char* sVN = lds + 32768;
  unsigned char* sNW = lds + 49152;
  unsigned char* sQT = lds + 65536;
  unsigned char* sKT = lds + 81920;
  unsigned char* sQK = lds + 98304;
  float* sU = reinterpret_cast<float*>(lds + 106496);
  const float* Uall = reinterpret_cast<const float*>(ws + O_PU);
  const u16* NWall = reinterpret_cast<const u16*>(ws + O_PNW);
  const u16* QTall = reinterpret_cast<const u16*>(ws + O_PQT);
  const u16* KTTall = reinterpret_cast<const u16*>(ws + O_PKTT);
  const u16* QKDall = reinterpret_cast<const u16*>(ws + O_PQKD);
  const float* EGL = reinterpret_cast<const float*>(ws + O_PEGL);
  float* OUT = reinterpret_cast<float*>(ws + (dir ? O_OB : O_OF));
  const int pid0 = ((b * 2 + dir) * 4 + h) * 36;
  u32x4 rg[11];
  int so[11];
#pragma unroll
  for (int i = 0; i < 2; ++i) { const int id = t + 512 * i, row = id >> 4, ch = id & 15; so[i] = 49152 + row * 256 + ((ch ^ (row & 7)) << 4); so[2 + i] = 65536 + row * 256 + ((ch ^ (row & 7)) << 4); }
#pragma unroll
  for (int i = 0; i < 2; ++i) { const int id = t + 512 * i, row = id >> 3, ch = id & 7; so[4 + i] = 81920 + row * 128 + ((ch ^ (row & 7)) << 4); }
  { const int row = t >> 3, ch = t & 7; so[6] = 98304 + row * 128 + ((ch ^ (row & 7)) << 4); }
#pragma unroll
  for (int i = 0; i < 4; ++i) so[7 + i] = 106496 + (t + 512 * i) * 16;
#define SCAN_GLOAD(pid)                                                                              \
  {                                                                                                   \
    const u32x4* g0 = reinterpret_cast<const u32x4*>(NWall + (size_t)(pid) * 8192);                  \
    const u32x4* g1 = reinterpret_cast<const u32x4*>(QTall + (size_t)(pid) * 8192);                  \
    const u32x4* g2 = reinterpret_cast<const u32x4*>(KTTall + (size_t)(pid) * 8192);                 \
    const u32x4* g3 = reinterpret_cast<const u32x4*>(QKDall + (size_t)(pid) * 4096);                 \
    const u32x4* g4 = reinterpret_cast<const u32x4*>(Uall + (size_t)(pid) * 8192);                   \
    rg[0] = g0[t]; rg[1] = g0[t + 512]; rg[2] = g1[t]; rg[3] = g1[t + 512]; rg[4] = g2[t]; rg[5] = g2[t + 512]; \
    rg[6] = g3[t]; rg[7] = g4[t]; rg[8] = g4[t + 512]; rg[9] = g4[t + 1024]; rg[10] = g4[t + 1536];   \
  }
#define SCAN_SWRITE() { _Pragma("unroll") for (int i = 0; i < 11; ++i) *reinterpret_cast<u32x4*>(lds + so[i]) = rg[i]; }
  SCAN_GLOAD(pid0 + scan_chunk(dir, 0))
  float egl = EGL[pid0 + scan_chunk(dir, 0)];
  for (int i = t; i < 32768 / 16; i += NTHR) reinterpret_cast<uint4*>(sST)[i] = make_uint4(0, 0, 0, 0);
  SCAN_SWRITE()
  f32x16 accS[2];
#pragma unroll
  for (int a = 0; a < 2; ++a)
#pragma unroll
    for (int i = 0; i < 16; ++i) accS[a][i] = 0.f;
  const int ct = w >> 2, et = w & 3;
  const int dt = w & 3, ep = (w >> 2) * 2;
  const int arow = ct * 32 + l31;
  const int krow = dt * 32 + l31;
  const int erow = et * 32 + l31;
  __syncthreads();
  for (int step = 0; step < 36; ++step) {
    const int n = scan_chunk(dir, step);
    const int nn = scan_chunk(dir, step < 35 ? step + 1 : 35);
    const int Rb = b * TPB + n * 64;
    SCAN_GLOAD(pid0 + nn)
    const float egl_next = EGL[pid0 + nn];
    {
      f32x16 acc;
#pragma unroll
      for (int x = 0; x < 16; ++x) {
        const int c = ct * 32 + 8 * (x >> 2) + 4 * hf + (x & 3);
        acc[x] = sU[c * 128 + et * 32 + l31];
      }
#pragma unroll
      for (int ks = 0; ks < 8; ++ks) {
        const int c = ks * 2 + hf;
        bf16x8 a = ldsfrag(sNW + arow * 256 + ((c ^ (arow & 7)) << 4));
        bf16x8 bb = ldsfrag(sST + erow * 256 + ((c ^ (erow & 7)) << 4));
        acc = mfma(a, bb, acc);
      }
#pragma unroll
      for (int g = 0; g < 4; ++g) {
        const int q = ct * 4 + g;
        uint2 v; v.x = pack2(acc[4 * g], acc[4 * g + 1]); v.y = pack2(acc[4 * g + 2], acc[4 * g + 3]);
        *reinterpret_cast<uint2*>(sVN + erow * 128 + ((q ^ (erow & 7)) << 4) + hf * 8) = v;
      }
    }
    __syncthreads();
    {
      f32x16 acc;
#pragma unroll
      for (int x = 0; x < 16; ++x) acc[x] = 0.f;
#pragma unroll
      for (int ks = 0; ks < 8; ++ks) {
        const int c = ks * 2 + hf;
        bf16x8 a = ldsfrag(sQT + arow * 256 + ((c ^ (arow & 7)) << 4));
        bf16x8 bb = ldsfrag(sST + erow * 256 + ((c ^ (erow & 7)) << 4));
        acc = mfma(a, bb, acc);
      }
#pragma unroll
      for (int ks = 0; ks < 4; ++ks) {
        const int c = ks * 2 + hf;
        bf16x8 a = ldsfrag(sQK + arow * 128 + ((c ^ (arow & 7)) << 4));
        bf16x8 bb = ldsfrag(sVN + erow * 128 + ((c ^ (erow & 7)) << 4));
        acc = mfma(a, bb, acc);
      }
#pragma unroll
      for (int x = 0; x < 16; ++x) {
        const int c = ct * 32 + 8 * (x >> 2) + 4 * hf + (x & 3);
        const int R = Rb + (dir ? 63 - c : c);
        OUT[(size_t)R * 512 + h * 128 + et * 32 + l31] = acc[x];
      }
    }
#pragma unroll
    for (int a = 0; a < 2; ++a) {
      const int er = (ep + a) * 32 + l31;
#pragma unroll
      for (int x = 0; x < 16; ++x) accS[a][x] *= egl;
#pragma unroll
      for (int ks = 0; ks < 4; ++ks) {
        const int c = ks * 2 + hf;
        bf16x8 ka = ldsfrag(sKT + krow * 128 + ((c ^ (krow & 7)) << 4));
        bf16x8 bb = ldsfrag(sVN + er * 128 + ((c ^ (er & 7)) << 4));
        accS[a] = mfma(ka, bb, accS[a]);
      }
    }
    __syncthreads();
#pragma unroll
    for (int a = 0; a < 2; ++a) {
      const int er = (ep + a) * 32 + l31;
#pragma unroll
      for (int g = 0; g < 4; ++g) {
        const int q = dt * 4 + g;
        uint2 v; v.x = pack2(accS[a][4 * g], accS[a][4 * g + 1]); v.y = pack2(accS[a][4 * g + 2], accS[a][4 * g + 3]);
        *reinterpret_cast<uint2*>(sST + er * 256 + ((q ^ (er & 7)) << 4) + hf * 8) = v;
      }
    }
    SCAN_SWRITE()
    egl = egl_next;
    __syncthreads();
  }
#undef SCAN_GLOAD
#undef SCAN_SWRITE
}

template <int DQK>
__device__ __forceinline__ uint4 att_kload(int i, int t, int krow0, const u16* k1, int k1s, const u16* kpe) {
  constexpr int CH = DQK / 8;
  const int id = t + 512 * i;
  const int key = id / CH, c = id - key * CH;
  const unsigned kr = (unsigned)(krow0 + key);
  const u16* src = k1 + (kr * (unsigned)k1s + (unsigned)c * 8u);
  if (DQK == 192) { if (c >= 16) src = kpe + (kr * 64u + (unsigned)(c - 16) * 8u); }
  return *reinterpret_cast<const uint4*>(src);
}
template <int DQK>
__device__ __forceinline__ void att_kstore(int i, int t, unsigned char* sK, uint4 v) {
  constexpr int CH = DQK / 8;
  const int id = t + 512 * i;
  const int key = id / CH, c = id - key * CH;
  const int sw = (DQK == 192) ? ((key >> 1) & 7) : (key & 15);
  *reinterpret_cast<uint4*>(sK + key * (DQK * 2) + ((c ^ sw) << 4)) = v;
}
__device__ __forceinline__ uint4 att_vload(int i, int t, int krow0, const u16* vsrc, int vs) {
  const int id = t + 512 * i;
  const int key = id >> 4, ch = id & 15;
  return *reinterpret_cast<const uint4*>(vsrc + ((unsigned)(krow0 + key) * (unsigned)vs + (unsigned)ch * 8u));
}
__device__ __forceinline__ void att_vstore(int i, int t, unsigned char* sV, uint4 v) {
  const int id = t + 512 * i;
  const int key = id >> 4, ch = id & 15;
  *reinterpret_cast<uint4*>(sV + 256 * key + 16 * (ch ^ (((key & 3) << 2) | ((key >> 2) & 3)))) = v;
}

template <int DQK>
__device__ __forceinline__ void attn_item(const P& p, int l, int b, int h, int qb, unsigned char* lds) {
  constexpr bool MLA = (DQK == 192);
  constexpr int KS = DQK / 16;
  constexpr int CH = DQK / 8;
  constexpr int KLD = CH * 64 / 512;
  unsigned char* ws = p.ws;
  const int t = tid(), lane = t & 63, w = t >> 6, hf = lane >> 5, l31 = lane & 31;
  const u16* PROJ = reinterpret_cast<const u16*>(ws + O_PROJ);
  const int rb = b * TPB;
  const bool lat = qb < 8;
  const int qrow = rb + (lat ? qb * 256 : 2048) + w * 32 + l31;
  const int kbase = lat ? rb : rb + 2048;
  const int ntile = lat ? 36 : 4;
  const int kvh = h >> 2;
  const u16* qsrc; const u16* k1; int k1s; const u16* vsrc; int vs; u16* odst; int os;
  if (MLA) {
    qsrc = reinterpret_cast<const u16*>(ws + O_QRAW) + (size_t)qrow * 768 + h * 192;
    k1 = reinterpret_cast<const u16*>(ws + O_KVRAW) + h * 256; k1s = 1024;
    vsrc = reinterpret_cast<const u16*>(ws + O_KVRAW) + h * 256 + 128; vs = 1024;
    odst = reinterpret_cast<u16*>(ws + O_OA) + (size_t)qrow * 512 + h * 128; os = 512;
  } else {
    qsrc = PROJ + (size_t)qrow * DINP + C_GQ + h * 128;
    k1 = reinterpret_cast<const u16*>(ws + O_GKN) + kvh * 128; k1s = 256;
    vsrc = reinterpret_cast<const u16*>(ws + O_GVC) + kvh * 128; vs = 256;
    odst = reinterpret_cast<u16*>(ws + O_OBQ) + (size_t)qrow * 1024 + h * 128; os = 1024;
  }
  (void)os;
  const u16* kpe = reinterpret_cast<const u16*>(ws + O_KPE);
  const float sc = (MLA ? 0.07216878364870322f : 0.08838834764831845f) * 1.4426950408889634f;
  bf16x8 qf[KS];
  {
    const int tq = (qrow - rb);
    const int prow = tq >> 6, pcol = tq & 63;
    if (MLA) {
      const float2* tm = reinterpret_cast<const float2*>(ws + O_ROPEM);
#pragma unroll
      for (int ks = 0; ks < 8; ++ks) qf[ks] = asfrag(*reinterpret_cast<const uint4*>(qsrc + ks * 16 + hf * 8));
#pragma unroll
      for (int pr = 0; pr < 2; ++pr) {
        uint4 va = *reinterpret_cast<const uint4*>(qsrc + (8 + 2 * pr) * 16 + hf * 8);
        uint4 vb = *reinterpret_cast<const uint4*>(qsrc + (9 + 2 * pr) * 16 + hf * 8);
        float xa[8] = {bflo(va.x), bfhi(va.x), bflo(va.y), bfhi(va.y), bflo(va.z), bfhi(va.z), bflo(va.w), bfhi(va.w)};
        float xb[8] = {bflo(vb.x), bfhi(vb.x), bflo(vb.y), bfhi(vb.y), bflo(vb.z), bfhi(vb.z), bflo(vb.w), bfhi(vb.w)};
        if (lat) {
          const int pos = pr ? pcol : prow;
#pragma unroll
          for (int j = 0; j < 8; ++j) {
            const float2 csn = tm[pos * 16 + 8 * hf + j];
            const float o1 = xa[j] * csn.x - xb[j] * csn.y, o2 = xb[j] * csn.x + xa[j] * csn.y;
            xa[j] = o1; xb[j] = o2;
          }
        }
        uint4 oa, ob;
        oa.x = pack2(xa[0], xa[1]); oa.y = pack2(xa[2], xa[3]); oa.z = pack2(xa[4], xa[5]); oa.w = pack2(xa[6], xa[7]);
        ob.x = pack2(xb[0], xb[1]); ob.y = pack2(xb[2], xb[3]); ob.z = pack2(xb[4], xb[5]); ob.w = pack2(xb[6], xb[7]);
        qf[(DQK == 192) ? 8 + 2 * pr : 0] = asfrag(oa); qf[(DQK == 192) ? 9 + 2 * pr : 1] = asfrag(ob);
      }
    } else {
      const u16* gq = reinterpret_cast<const u16*>(ws + O_GQN) + (size_t)qrow * 1024 + h * 128;
#pragma unroll
      for (int ks = 0; ks < 8; ++ks) qf[ks] = asfrag(*reinterpret_cast<const uint4*>(gq + ks * 16 + hf * 8));
    }
  }
  f32x16 O[4];
#pragma unroll
  for (int a = 0; a < 4; ++a)
#pragma unroll
    for (int i = 0; i < 16; ++i) O[a][i] = 0.f;
  float mrun = -1e30f, lsum = 0.f;
  uint4 rk0, rk1, rk2 = make_uint4(0, 0, 0, 0), rv0, rv1;
  constexpr int STG = 64 * DQK * 2 + 16384;
  const int kbase_l = l31 * (DQK * 2);
  const int kxm = (hf ^ (MLA ? ((l31 >> 1) & 7) : (l31 & 15))) << 4;
  int vb2[2], vq6;
  {
    const int g = (lane >> 4) & 1, q = (lane & 15) >> 2, pp = lane & 3;
    const int basel = 256 * (4 * hf + q) + 8 * (pp & 1);
    vq6 = q << 6;
#pragma unroll
    for (int r2 = 0; r2 < 2; ++r2) {
      const int low2 = (2 * g + (pp >> 1)) ^ ((2 * r2 + hf) & 3);
      vb2[r2] = 64 * DQK * 2 + basel + 2048 * r2 + 16 * low2;
    }
  }
#define ATT_LOAD(kr0)                                                  \
  rk0 = att_kload<DQK>(0, t, (kr0), k1, k1s, kpe);                     \
  rk1 = att_kload<DQK>(1, t, (kr0), k1, k1s, kpe);                     \
  if (KLD > 2) rk2 = att_kload<DQK>(2, t, (kr0), k1, k1s, kpe);        \
  rv0 = att_vload(0, t, (kr0), vsrc, vs);                              \
  rv1 = att_vload(1, t, (kr0), vsrc, vs);
#define ATT_STORE(stg)                                                 \
  att_kstore<DQK>(0, t, (stg), rk0);                                   \
  att_kstore<DQK>(1, t, (stg), rk1);                                   \
  if (KLD > 2) att_kstore<DQK>(2, t, (stg), rk2);                      \
  att_vstore(0, t, (stg) + 64 * DQK * 2, rv0);                         \
  att_vstore(1, t, (stg) + 64 * DQK * 2, rv1);
  ATT_LOAD(kbase)
  ATT_STORE(lds)
  __syncthreads();
  for (int kt = 0; kt < ntile; ++kt) {
    const bool more = kt + 1 < ntile;
    unsigned char* cur = lds + (kt & 1) * STG;
    if (more) { ATT_LOAD(kbase + (kt + 1) * 64) }
    f32x16 st[2];
#pragma unroll
    for (int mt = 0; mt < 2; ++mt)
#pragma unroll
      for (int i = 0; i < 16; ++i) st[mt][i] = 0.f;
    {
      constexpr int NBM = KS / 4;
      constexpr int NBT = 2 * NBM;
      bf16x8 fr[2][4];
#define KFRAG(mt, ks) ldsfrag(cur + kbase_l + ((MLA ? (((ks) & 3) << 5) : ((((ks) >> 2) << 7) | (((ks) & 3) << 5))) ^ kxm) + (mt) * (32 * DQK * 2) + (MLA ? ((ks) >> 2) * 128 : 0))
#pragma unroll
      for (int i = 0; i < 4; ++i) fr[0][i] = KFRAG(0, i);
      __builtin_amdgcn_sched_barrier(0);
#pragma unroll
      for (int q = 0; q < NBT; ++q) {
        if (q + 1 < NBT) {
          const int mtn = (q + 1) / NBM, k0n = ((q + 1) % NBM) * 4;
#pragma unroll
          for (int i = 0; i < 4; ++i) fr[(q + 1) & 1][i] = KFRAG(mtn, k0n + i);
        }
        const int mtc = q / NBM, k0c = (q % NBM) * 4;
#pragma unroll
        for (int i = 0; i < 4; ++i) st[mtc] = mfma(fr[q & 1][i], qf[k0c + i], st[mtc]);
        __builtin_amdgcn_sched_barrier(0);
      }
#undef KFRAG
    }
    float mx = -1e30f;
#pragma unroll
    for (int mt = 0; mt < 2; ++mt)
#pragma unroll
      for (int i = 0; i < 16; ++i) mx = fmaxf(mx, st[mt][i]);
    mx = fmaxf(mx, __shfl_xor(mx, 32));
    const float mnew = fmaxf(mrun, mx * sc);
    if (__builtin_amdgcn_ballot_w64(mnew > mrun) != 0ull) {
      const float alpha = __builtin_amdgcn_exp2f(mrun - mnew);
      lsum *= alpha;
#pragma unroll
      for (int a = 0; a < 4; ++a)
#pragma unroll
        for (int i = 0; i < 16; ++i) O[a][i] *= alpha;
    }
    mrun = mnew;
    float ps = 0.f;
#pragma unroll
    for (int mt = 0; mt < 2; ++mt)
#pragma unroll
      for (int i = 0; i < 16; ++i) {
        const float pv = __builtin_amdgcn_exp2f(st[mt][i] * sc - mnew);
        st[mt][i] = pv; ps += pv;
      }
    lsum += ps;
    const LAS unsigned char* curl = (const LAS unsigned char*)cur;
    {
      v8s va[4], vb[4];
#define VFRAG(dst, s_)                                                                                                 \
      _Pragma("unroll") for (int et = 0; et < 4; ++et) {                                                               \
        const v4s lo = __builtin_amdgcn_ds_read_tr16_b64_v4i16((LAS v4s*)(curl + vb2[0] + ((et << 6) ^ vq6) + 4096 * (s_)));         \
        const v4s hi = __builtin_amdgcn_ds_read_tr16_b64_v4i16((LAS v4s*)(curl + vb2[1] + ((et << 6) ^ vq6) + 4096 * (s_)));         \
        dst[et] = __builtin_shufflevector(lo, hi, 0, 1, 2, 3, 4, 5, 6, 7);                                             \
      }
#define PVMMA(src, s_)                                                                                                 \
      {                                                                                                                \
        uint4 pk;                                                                                                      \
        const int mt = (s_) >> 1, o8 = 8 * ((s_) & 1);                                                                 \
        pk.x = pack2(st[mt][o8 + 0], st[mt][o8 + 1]); pk.y = pack2(st[mt][o8 + 2], st[mt][o8 + 3]);                    \
        pk.z = pack2(st[mt][o8 + 4], st[mt][o8 + 5]); pk.w = pack2(st[mt][o8 + 6], st[mt][o8 + 7]);                    \
        const bf16x8 pf = asfrag(pk);                                                                                  \
        _Pragma("unroll") for (int et = 0; et < 4; ++et) O[et] = mfma(__builtin_bit_cast(bf16x8, src[et]), pf, O[et]); \
      }
      VFRAG(va, 0)
      __builtin_amdgcn_sched_barrier(0);
      VFRAG(vb, 1)
      PVMMA(va, 0)
      __builtin_amdgcn_sched_barrier(0);
      VFRAG(va, 2)
      PVMMA(vb, 1)
      __builtin_amdgcn_sched_barrier(0);
      VFRAG(vb, 3)
      PVMMA(va, 2)
      __builtin_amdgcn_sched_barrier(0);
      PVMMA(vb, 3)
#undef VFRAG
#undef PVMMA
    }
    if (more) { ATT_STORE(lds + ((kt + 1) & 1) * STG) }
    __syncthreads();
  }
#undef ATT_LOAD
#undef ATT_STORE
  lsum += __shfl_xor(lsum, 32);
  const float inv = 1.f / lsum;
#pragma unroll
  for (int et = 0; et < 4; ++et)
#pragma unroll
    for (int g = 0; g < 4; ++g) {
      const int e0 = et * 32 + 8 * g + 4 * hf;
      uint2 o;
      o.x = pack2(O[et][4 * g] * inv, O[et][4 * g + 1] * inv);
      o.y = pack2(O[et][4 * g + 2] * inv, O[et][4 * g + 3] * inv);
      *reinterpret_cast<uint2*>(odst + e0) = o;
    }
  __syncthreads();
}

__device__ __forceinline__ void phase_mixers(const P& p, int l, unsigned char* lds, int* sitem, int cidx, int only = 0) {
  int* ctr = reinterpret_cast<int*>(p.ws + O_CTR) + cidx;
  const int nscan = 32, nmla = 128, ngqa = 256;
  const int nctx = (l == 0) ? 48 : 0;
  const int total = nscan + nmla + ngqa + nctx;
  for (;;) {
    if (threadIdx.x == 0) *sitem = atomicAdd(ctr, 1);
    __syncthreads();
    int it = *sitem;
    __syncthreads();
    if (it >= total) break;
    if (only == 1 && it >= nscan) break;
    if (only == 2 && (it < nscan + nmla || it >= nscan + nmla + ngqa)) continue;
    if (only == 3 && (it < nscan || it >= nscan + nmla)) continue;
    if (it < nscan) { gdn_scan_item(p, it, lds); __syncthreads(); continue; }
    it -= nscan;
    int typ, b, h, qb;
    if (it < nmla) { typ = 0; b = it >> 5; h = (it >> 3) & 3; qb = it & 7; }
    else if (it < nmla + ngqa) { it -= nmla; typ = 1; b = it >> 6; h = (it >> 3) & 7; qb = it & 7; }
    else if (it < nmla + ngqa + 16) { it -= nmla + ngqa; typ = 0; b = it >> 2; h = it & 3; qb = 8; }
    else { it -= nmla + ngqa + 16; typ = 1; b = it >> 3; h = it & 7; qb = 8; }
    if (typ == 0) attn_item<192>(p, l, b, h, qb, lds);
    else attn_item<128>(p, l, b, h, qb, lds);
  }
}

__device__ __forceinline__ void phase_gdn_out(const P& p, int l) {
  unsigned char* ws = p.ws;
  const int t = tid(), lane = t & 63, w = t >> 6;
  const float* __restrict__ OF = reinterpret_cast<const float*>(ws + O_OF);
  const float* __restrict__ OB = reinterpret_cast<const float*>(ws + O_OB);
  const u16* __restrict__ PROJ = reinterpret_cast<const u16*>(ws + O_PROJ);
  u16* OC = reinterpret_cast<u16*>(ws + O_OC);
  const float* g = p.in[17] + l * 128 + (lane & 15) * 8;
  const float4 ga = *reinterpret_cast<const float4*>(g), gb = *reinterpret_cast<const float4*>(g + 4);
  const float gg[8] = {ga.x, ga.y, ga.z, ga.w, gb.x, gb.y, gb.z, gb.w};
  const int nrow = (l == 1) ? 8192 : MROWS;
  for (int q0 = (blockIdx.x * 8 + w) * 2; q0 < nrow; q0 += gridDim.x * 16) {
    float4 fa[2][2], fb[2][2]; uint4 og[2]; int Rr[2];
#pragma unroll
    for (int u = 0; u < 2; ++u) {
      const int q = q0 + u;
      const int R = (l == 1) ? ((q >> 11) * TPB + (q & 2047)) : q;
      Rr[u] = R;
      const size_t o = (size_t)R * 512 + lane * 8;
      fa[u][0] = *reinterpret_cast<const float4*>(OF + o); fa[u][1] = *reinterpret_cast<const float4*>(OF + o + 4);
      fb[u][0] = *reinterpret_cast<const float4*>(OB + o); fb[u][1] = *reinterpret_cast<const float4*>(OB + o + 4);
      og[u] = *reinterpret_cast<const uint4*>(PROJ + (size_t)R * DINP + C_OG + lane * 8);
    }
#pragma unroll
    for (int u = 0; u < 2; ++u) {
      float a[8] = {fa[u][0].x + fb[u][0].x, fa[u][0].y + fb[u][0].y, fa[u][0].z + fb[u][0].z, fa[u][0].w + fb[u][0].w,
                    fa[u][1].x + fb[u][1].x, fa[u][1].y + fb[u][1].y, fa[u][1].z + fb[u][1].z, fa[u][1].w + fb[u][1].w};
      float ss = 0.f;
#pragma unroll
      for (int j = 0; j < 8; ++j) ss += a[j] * a[j];
#pragma unroll
      for (int o = 8; o > 0; o >>= 1) ss += __shfl_xor(ss, o);
      const float rs = rsqrtf(ss * (1.f / 128.f) + EPS);
      float gt[8];
      unpack8(og[u], gt);
      uint4 o;
      o.x = pack2(a[0] * rs * gg[0] * siluf(gt[0]), a[1] * rs * gg[1] * siluf(gt[1]));
      o.y = pack2(a[2] * rs * gg[2] * siluf(gt[2]), a[3] * rs * gg[3] * siluf(gt[3]));
      o.z = pack2(a[4] * rs * gg[4] * siluf(gt[4]), a[5] * rs * gg[5] * siluf(gt[5]));
      o.w = pack2(a[6] * rs * gg[6] * siluf(gt[6]), a[7] * rs * gg[7] * siluf(gt[7]));
      *reinterpret_cast<uint4*>(OC + (size_t)Rr[u] * 512 + lane * 8) = o;
    }
  }
}

#define XB_TMO      128
#define XB_XCNT(j)  (256  + 64 * (j))
#define XB_XSUB(j)  (1280 + 64 * (j))
#define XB_XGEN(j)  (2304 + 64 * (j))
#define XB_TOP      3328
#define XB_TOPGEN   3392
#define XCD_BAR_WORDS 3456
#define XB_SPIN_CAP (1u << 18)
__device__ __forceinline__ unsigned xb_ld(unsigned* p)              { return __hip_atomic_load(p, __ATOMIC_RELAXED, __HIP_MEMORY_SCOPE_AGENT); }
__device__ __forceinline__ unsigned xb_add(unsigned* p, unsigned v) { return __hip_atomic_fetch_add(p, v, __ATOMIC_RELAXED, __HIP_MEMORY_SCOPE_AGENT); }
__device__ __forceinline__ unsigned xb_xcc_id() { return (unsigned)__builtin_amdgcn_s_getreg((3 << 11) | 20) & 0xFu; }
#define XB_SPIN(cond, bar) do { unsigned _sp = 0; while (cond) { \
    if ((++_sp & 255u) == 0u) { if (xb_ld(&(bar)[XB_TMO])) break; if (_sp > XB_SPIN_CAP) { atomicAdd(&(bar)[XB_TMO], 1u); break; } } } } while (0)
struct XcdBarrier { unsigned* bar; unsigned x; volatile __attribute__((address_space(3))) unsigned* st; };
__device__ __forceinline__ XcdBarrier xcd_barrier_post(unsigned* bar, volatile __attribute__((address_space(3))) unsigned* st) {
  XcdBarrier b; b.bar = bar; b.x = xb_xcc_id(); b.st = st;
  if (threadIdx.x == 0) (void)xb_add(&bar[XB_XCNT(b.x)], 1u);
  return b;
}
__device__ __forceinline__ void xcd_barrier_complete(unsigned* bar, unsigned x, unsigned& nloc, unsigned& nx) {
  const unsigned G = gridDim.x * gridDim.y * gridDim.z;
  unsigned sum, cnt, mine, sp = 0u;
  for (;;) {
    sum = 0u; cnt = 0u; mine = 0u;
#pragma unroll
    for (unsigned j = 0; j < 16; ++j) { const unsigned c = xb_ld(&bar[XB_XCNT(j)]); sum += c; cnt += (c > 0u) ? 1u : 0u; mine = (j == x) ? c : mine; }
    if (sum == G) break;
    __builtin_amdgcn_s_sleep(1);
    if ((++sp & 255u) == 0u) { if (xb_ld(&bar[XB_TMO])) break; if (sp > XB_SPIN_CAP) { atomicAdd(&bar[XB_TMO], 1u); break; } }
  }
  nloc = mine > 0u ? mine : 1u; nx = cnt > 0u ? cnt : 1u;
}
__device__ __forceinline__ void xcd_barrier(const XcdBarrier& b) {
  asm volatile("s_waitcnt vmcnt(0)" ::: "memory");
  __syncthreads();
  if (threadIdx.x == 0) {
    unsigned* bar = b.bar;
    __builtin_amdgcn_s_waitcnt(0);
    unsigned nloc = b.st[0], nx = b.st[1];
    if (nloc == 0u) { xcd_barrier_complete(bar, b.x, nloc, nx); b.st[0] = nloc; b.st[1] = nx; }
    const unsigned old = xb_add(&bar[XB_XSUB(b.x)], 1u);
    const unsigned gen = old / nloc;
    if (old + 1u == (gen + 1u) * nloc) {
      __builtin_amdgcn_fence(__ATOMIC_RELEASE, "agent");
      asm volatile("s_waitcnt vmcnt(0)" ::: "memory");
      const unsigned og = xb_add(&bar[XB_TOP], 1u);
      const unsigned tg = og / nx;
      if (og + 1u == (tg + 1u) * nx) xb_add(&bar[XB_TOPGEN], 1u);
      else XB_SPIN(xb_ld(&bar[XB_TOPGEN]) == tg, bar);
      __builtin_amdgcn_fence(__ATOMIC_ACQUIRE, "agent");
      xb_add(&bar[XB_XGEN(b.x)], 1u);
      asm volatile("s_waitcnt vmcnt(0)" ::: "memory");
    } else {
      XB_SPIN(xb_ld(&bar[XB_XGEN(b.x)]) == gen, bar);
      __builtin_amdgcn_fence(__ATOMIC_ACQUIRE, "agent");
      asm volatile("s_waitcnt vmcnt(0)" ::: "memory");
    }
  }
  __syncthreads();
}

constexpr int NPHASE = 24 + ((PROBE == 1 || PROBE == 3 || PROBE == 2 || PROBE == 5 || PROBE == 6 || PROBE == 7 || PROBE == 8 || PROBE == 11 || PROBE == 12 || PROBE == 13) ? 2 : 0) + (PROBE == 4 ? 1 : 0) + (PROBE == 9 ? 10 : 0);

__global__ void __launch_bounds__(NTHR) mega(P p) {
  extern __shared__ __attribute__((aligned(16))) unsigned char lds[];
  float* sred = reinterpret_cast<float*>(lds + LDS_MAIN);
  int* sitem = reinterpret_cast<int*>(lds + LDS_MAIN + 64);
  unsigned char* ws = p.ws;
  int ph = 0;
  volatile __attribute__((address_space(3))) unsigned* bst = (volatile __attribute__((address_space(3))) unsigned*)(lds + LDS_MAIN + 128);
  if (threadIdx.x < 2) bst[threadIdx.x] = 0u;
  __syncthreads();
  XcdBarrier xbar; xbar.bar = reinterpret_cast<unsigned*>(ws + O_BAR); xbar.x = 0; xbar.st = bst;
#define PH_BEGIN if (ph >= p.lo && ph < p.hi) {
#define PH_END   if (ph + 1 < p.hi) { if (ph == 0) { cg::this_grid().sync(); xbar = xcd_barrier_post(reinterpret_cast<unsigned*>(ws + O_BAR), bst); } else xcd_barrier(xbar); } } ++ph;

  PH_BEGIN
    if (blockIdx.x == 0 && threadIdx.x < 64) reinterpret_cast<int*>(ws + O_CTR)[threadIdx.x] = 0;
    if (blockIdx.x == 2) for (int i = threadIdx.x; i < XCD_BAR_WORDS; i += NTHR) reinterpret_cast<unsigned*>(ws + O_BAR)[i] = 0u;
    if (blockIdx.x == 1) {
      float2* tg = reinterpret_cast<float2*>(ws + O_ROPEG);
      float2* tm = reinterpret_cast<float2*>(ws + O_ROPEM);
#pragma unroll 1
      for (int i = threadIdx.x; i < 64 * 32 + 64 * 16; i += NTHR) {
        const bool isg = i < 2048;
        const int j = isg ? i : i - 2048;
        const int pos = isg ? (j >> 5) : (j >> 4);
        const int fi = isg ? (j & 31) : (j & 15);
        const float ang = (float)pos * exp2f(-(float)fi * (isg ? (LOG2_THETA / 32.f) : (LOG2_THETA / 16.f)));
        float2 v; v.x = cosf(ang); v.y = sinf(ang);
        if (isg) tg[j] = v; else tm[j] = v;
      }
    }
    phase_mod(p, lds);
    phase_convert(p, 0, lds, 0, sitem);
  PH_END
#if PROBE == 4
  PH_BEGIN
    phase_convert(p, 0, lds, 0, sitem);
  PH_END
#endif
#if PROBE == 9
  for (int e = 0; e < 10; ++e) {
  PH_BEGIN
  PH_END
  }
#endif
  for (int l = 0; l < 2; ++l) {
    PH_BEGIN
      phase_norm_mod(p, l, 0, l == 0, false, l == 1 && gridDim.x == 256);
      if (l == 1) phase_convert(p, 1, lds, 0, sitem);
    PH_END
    PH_BEGIN
      u16* PROJ = reinterpret_cast<u16*>(ws + O_PROJ);
      gemm_phase<true>(reinterpret_cast<const u16*>(ws + O_H), reinterpret_cast<const u16*>(ws + O_WIN), 2048, 36, 43, lds,
                    [=](int r, int c, f32x4 v, int part) { st_bf16x4(PROJ + (size_t)r * DINP + c, v); }, l == 1 ? 3 : 0);
      phase_convert(p, l, lds, 1, sitem);
    PH_END
#if PROBE == 5
    PH_BEGIN
      u16* PROJ = reinterpret_cast<u16*>(ws + O_PROJ);
      gemm_phase<true>(reinterpret_cast<const u16*>(ws + O_H), reinterpret_cast<const u16*>(ws + O_WIN), 2048, 36, 43, lds,
                    [=](int r, int c, f32x4 v, int part) { st_bf16x4(PROJ + (size_t)r * DINP + c, v); }, l == 1 ? 3 : 0);
      phase_convert(p, l, lds, 1, sitem);
    PH_END
#endif
    PH_BEGIN
      phase_post(p, l);
    PH_END
#if PROBE == 3
    PH_BEGIN
      phase_post(p, l);
    PH_END
#endif
    PH_BEGIN
      u16* QRAW = reinterpret_cast<u16*>(ws + O_QRAW);
      u16* KVRAW = reinterpret_cast<u16*>(ws + O_KVRAW);
      gemm_phase<true>(reinterpret_cast<const u16*>(ws + O_CQN), reinterpret_cast<const u16*>(ws + O_WQB), 512, 36, 3, lds,
                    [=](int r, int c, f32x4 v, int part) { st_bf16x4(QRAW + (size_t)r * 768 + c, v); }, l == 1 ? 1 : 0, 0);
      gemm_phase<true>(reinterpret_cast<const u16*>(ws + O_CKVN), reinterpret_cast<const u16*>(ws + O_WKVB), 512, 36, 4, lds,
                    [=](int r, int c, f32x4 v, int part) { st_bf16x4(KVRAW + (size_t)r * 1024 + c, v); }, 0, (gridDim.x >= 252) ? 108 : 0);
      phase_qnorm(p, l);
      {
        int* pctr = reinterpret_cast<int*>(ws + O_CTR) + 6 + l;
        for (;;) {
          if (threadIdx.x == 0) *sitem = atomicAdd(pctr, 1);
          __syncthreads();
          const int it = *sitem;
          __syncthreads();
          if (it >= NPREP) break;
          gdn_prep_item(p, it, lds);
        }
      }
    PH_END
#if PROBE == 2
    PH_BEGIN
      u16* QRAW = reinterpret_cast<u16*>(ws + O_QRAW);
      u16* KVRAW = reinterpret_cast<u16*>(ws + O_KVRAW);
      gemm_phase<true>(reinterpret_cast<const u16*>(ws + O_CQN), reinterpret_cast<const u16*>(ws + O_WQB), 512, 36, 3, lds,
                    [=](int r, int c, f32x4 v, int part) { st_bf16x4(QRAW + (size_t)r * 768 + c, v); }, l == 1 ? 1 : 0, 0);
      gemm_phase<true>(reinterpret_cast<const u16*>(ws + O_CKVN), reinterpret_cast<const u16*>(ws + O_WKVB), 512, 36, 4, lds,
                    [=](int r, int c, f32x4 v, int part) { st_bf16x4(KVRAW + (size_t)r * 1024 + c, v); }, 0, (gridDim.x >= 252) ? 108 : 0);
      {
        int* pctr = reinterpret_cast<int*>(ws + O_CTR) + 8 + l;
        for (;;) {
          if (threadIdx.x == 0) *sitem = atomicAdd(pctr, 1);
          __syncthreads();
          const int it = *sitem;
          __syncthreads();
          if (it >= NPREP) break;
          gdn_prep_item(p, it, lds);
        }
      }
    PH_END
#endif
    PH_BEGIN
      phase_mixers(p, l, lds, sitem, l);
    PH_END
#if PROBE == 1
    PH_BEGIN
      phase_mixers(p, l, lds, sitem, l + 2);
    PH_END
#endif
#if PROBE == 11 || PROBE == 12 || PROBE == 13
    PH_BEGIN
      phase_mixers(p, l, lds, sitem, l + 2, PROBE - 10);
    PH_END
#endif
    PH_BEGIN
      phase_gdn_out(p, l);
    PH_END
#if PROBE == 6
    PH_BEGIN
      phase_gdn_out(p, l);
    PH_END
#endif
    PH_BEGIN
      const u16* PROJ = reinterpret_cast<const u16*>(ws + O_PROJ);
      float* T = reinterpret_cast<float*>(ws + O_PU);
      u16* Y = reinterpret_cast<u16*>(ws + O_H);
      gemm_phase<true>(reinterpret_cast<const u16*>(ws + O_OA), reinterpret_cast<const u16*>(ws + O_WUPA), 512, 36, 8, lds,
                    [=](int r, int c, f32x4 v, int part) {
                      const uint2 gq = *reinterpret_cast<const uint2*>(PROJ + (size_t)r * DINP + C_BG + c);
                      f32x4 o; o[0] = sigmf(bflo(gq.x)) * v[0]; o[1] = sigmf(bfhi(gq.x)) * v[1]; o[2] = sigmf(bflo(gq.y)) * v[2]; o[3] = sigmf(bfhi(gq.y)) * v[3];
                      *reinterpret_cast<f32x4*>(T + (size_t)r * 2048 + c) = o; }, l == 1 ? 1 : 0);
      gemm_phase<true>(reinterpret_cast<const u16*>(ws + O_OBQ), reinterpret_cast<const u16*>(ws + O_WUPB), 1024, 36, 8, lds,
                    [=](int r, int c, f32x4 v, int part) {
                      const uint2 gq = *reinterpret_cast<const uint2*>(PROJ + (size_t)r * DINP + C_BG + 2048 + c);
                      f32x4 o = *reinterpret_cast<const f32x4*>(T + (size_t)r * 2048 + c);
                      o[0] += sigmf(bflo(gq.x)) * v[0]; o[1] += sigmf(bfhi(gq.x)) * v[1]; o[2] += sigmf(bflo(gq.y)) * v[2]; o[3] += sigmf(bfhi(gq.y)) * v[3];
                      *reinterpret_cast<f32x4*>(T + (size_t)r * 2048 + c) = o; }, l == 1 ? 1 : 0);
      gemm_phase<true>(reinterpret_cast<const u16*>(ws + O_OC), reinterpret_cast<const u16*>(ws + O_WUPC), 512, 36, 8, lds,
                    [=](int r, int c, f32x4 v, int part) {
                      const uint2 gq = *reinterpret_cast<const uint2*>(PROJ + (size_t)r * DINP + C_BG + 4096 + c);
                      f32x4 o = *reinterpret_cast<const f32x4*>(T + (size_t)r * 2048 + c);
                      o[0] += sigmf(bflo(gq.x)) * v[0]; o[1] += sigmf(bfhi(gq.x)) * v[1]; o[2] += sigmf(bflo(gq.y)) * v[2]; o[3] += sigmf(bfhi(gq.y)) * v[3];
                      st_bf16x4(Y + (size_t)r * 2048 + c, o); }, l == 1 ? 1 : 0);
    PH_END
    PH_BEGIN
      float* XRES = reinterpret_cast<float*>(ws + O_XRES);
      float* PART = reinterpret_cast<float*>(ws + O_PU);
      const float* xin_lat = p.in[0];
      const float* xin_ctx = p.in[2];
      const float* MOD = reinterpret_cast<const float*>(ws + O_MOD) + (size_t)l * 5 * 12288;
      gemm_phase<false>(reinterpret_cast<const u16*>(ws + O_H), reinterpret_cast<const u16*>(ws + O_WOUT), 2048, 36, 8, lds,
                    [=](int r, int c, f32x4 v, int part) {
                      const int b = r / TPB; const int mr = (r - b * TPB < 2048) ? b : 4;
                      const f32x4 md = *reinterpret_cast<const f32x4*>(MOD + (size_t)mr * 12288 + 2 * 2048 + c);
                      const f32x4 dv = md * v;
                      float* xf = XRES + (size_t)r * 2048 + c;
                      if (part >= 0) {
                        const int cr = b * 256 + (r - b * TPB - 2048);
                        *reinterpret_cast<f32x4*>(PART + ((size_t)part * 1024 + cr) * 2048 + c) = dv;
                      } else {
                        const int tt_ = r - b * TPB;
                        const float* xsrc = (l == 1) ? xf
                                          : ((tt_ < 2048) ? (xin_lat + ((size_t)b * 2048 + tt_) * 2048 + c) : (xin_ctx + ((size_t)b * 256 + (tt_ - 2048)) * 2048 + c));
                        *reinterpret_cast<f32x4*>(xf) = *reinterpret_cast<const f32x4*>(xsrc) + dv;
                      }
                    }, l == 1 ? 1 : 2);
    PH_END
    PH_BEGIN
      phase_norm_mod(p, l, 1, false, l == 1, l == 0 && gridDim.x == 256);
    PH_END
#if PROBE == 7
    PH_BEGIN
      phase_norm_mod(p, l, 1, false, l == 1, l == 0 && gridDim.x == 256);
    PH_END
#endif
    PH_BEGIN
      u16* F = reinterpret_cast<u16*>(ws + O_PROJ);
      gemm_phase<true>(reinterpret_cast<const u16*>(ws + O_H), reinterpret_cast<const u16*>(ws + O_WFF1), 2048, 36, 32, lds,
                    [=](int r, int c, f32x4 v, int part) {
                      f32x4 q; q[0] = fmaxf(v[0], 0.f); q[1] = fmaxf(v[1], 0.f); q[2] = fmaxf(v[2], 0.f); q[3] = fmaxf(v[3], 0.f);
                      st_bf16x4(F + (size_t)r * DFF + c, q * q); }, l == 1 ? 1 : 0);
    PH_END
#if PROBE == 8
    PH_BEGIN
      u16* F = reinterpret_cast<u16*>(ws + O_PROJ);
      gemm_phase<true>(reinterpret_cast<const u16*>(ws + O_H), reinterpret_cast<const u16*>(ws + O_WFF1), 2048, 36, 32, lds,
                    [=](int r, int c, f32x4 v, int part) {
                      f32x4 q; q[0] = fmaxf(v[0], 0.f); q[1] = fmaxf(v[1], 0.f); q[2] = fmaxf(v[2], 0.f); q[3] = fmaxf(v[3], 0.f);
                      st_bf16x4(F + (size_t)r * DFF + c, q * q); }, l == 1 ? 1 : 0);
    PH_END
#endif
    PH_BEGIN
      float* XRES = reinterpret_cast<float*>(ws + O_XRES);
      float* PART = reinterpret_cast<float*>(ws + O_PU);
      const float* MOD = reinterpret_cast<const float*>(ws + O_MOD) + (size_t)l * 5 * 12288;
      gemm_phase<false>(reinterpret_cast<const u16*>(ws + O_PROJ), reinterpret_cast<const u16*>(ws + O_WFF2), DFF, 36, 8, lds,
                    [=](int r, int c, f32x4 v, int part) {
                      const int b = r / TPB; const int mr = (r - b * TPB < 2048) ? b : 4;
                      const f32x4 md = *reinterpret_cast<const f32x4*>(MOD + (size_t)mr * 12288 + 5 * 2048 + c);
                      const f32x4 dv = md * v;
                      float* xf = XRES + (size_t)r * 2048 + c;
                      if (part >= 0) {
                        const int cr = b * 256 + (r - b * TPB - 2048);
                        *reinterpret_cast<f32x4*>(PART + ((size_t)part * 1024 + cr) * 2048 + c) = dv;
                      } else {
                        f32x4* xp = reinterpret_cast<f32x4*>(xf);
                        *xp = *xp + dv;
                      }
                    }, l == 1 ? 1 : 2);
    PH_END
  }
  PH_BEGIN
    phase_final(p);
  PH_END
#undef PH_BEGIN
#undef PH_END
}

extern "C" void kernel_launch(void* const* d_in, const int* in_sizes, int n_in, void* d_out, int out_size, void* d_ws,
                              size_t ws_size, hipStream_t stream) {
  static int grid = 0;
  if (grid == 0) {
    if (n_in != 26 || ws_size < WS_END) { fprintf(stderr, "kernel_launch: bad setup n_in=%d ws=%zu need %zu\n", n_in, ws_size, (size_t)WS_END); grid = -1; return; }
    int dev = 0, cus = 0, per_cu = 0;
    hipGetDevice(&dev);
    hipDeviceGetAttribute(&cus, hipDeviceAttributeMultiprocessorCount, dev);
    hipFuncSetAttribute((const void*)mega, hipFuncAttributeMaxDynamicSharedMemorySize, LDS_BYTES);
    hipOccupancyMaxActiveBlocksPerMultiprocessor(&per_cu, (const void*)mega, NTHR, LDS_BYTES);
    if (per_cu < 1) per_cu = 1;
    grid = cus * per_cu;
    (void)hipGetLastError();
  }
  if (grid < 0) return;
  P p{};
  for (int i = 0; i < 26; ++i) p.in[i] = (const float*)d_in[i];
  p.out = (float*)d_out;
  p.ws = (unsigned char*)d_ws;
#if MULTI
  for (int ph = 0; ph < NPHASE; ++ph) {
    p.lo = ph; p.hi = ph + 1;
    hipLaunchKernelGGL(mega, dim3(grid), dim3(NTHR), LDS_BYTES, stream, p);
  }
#else
  p.lo = 0; p.hi = NPHASE;
  void* args[] = {&p};
  hipError_t e = hipLaunchCooperativeKernel((const void*)mega, dim3(grid), dim3(NTHR), args, LDS_BYTES, stream);
  if (e != hipSuccess) fprintf(stderr, "cooperative launch failed: %s (grid %d)\n", hipGetErrorString(e), grid);
#endif
}
```
